# Optimizing an MI355X kernel written in HIP

```python
import jax, jax.numpy as jnp
from jax import lax
import numpy as np

D_MODEL = 4096
BATCH = 1
SEQ = 8192
DEPTH = 2

N_MIXERS = 2
N_RET_LAYERS = (DEPTH + 1) // N_MIXERS
N_FNO_LAYERS = DEPTH // N_MIXERS
RET_HEADS = 16
RET_QK_DIM = D_MODEL // RET_HEADS
RET_V_DIM = 2 * RET_QK_DIM
RET_V_WIDTH = RET_HEADS * RET_V_DIM
RET_IN_WIDTH = 2 * D_MODEL + 2 * RET_V_WIDTH
RET_CHUNK = 128
ROPE_BASE = 10000.0
FNO_GROUPS = 8
FNO_GROUP_DIM = D_MODEL // FNO_GROUPS
D_FF = 4 * D_MODEL
N_MOD = 6
EPS = 1e-6

kernel_name = "hybrid_retention_fourier_adaln_encoder"


def rms_norm(x, g):
    xf = x.astype(jnp.float32)
    y = xf * lax.rsqrt(jnp.mean(xf * xf, axis=-1, keepdims=True) + EPS)
    return (y * g.astype(jnp.float32)).astype(x.dtype)


def adaln_params(c, w, b):
    m = jax.nn.silu(c) @ w + b
    return jnp.split(m[:, None, :], N_MOD, axis=-1)


def rotary(x, pos):
    half = x.shape[-1] // 2
    inv = ROPE_BASE ** (-jnp.arange(half, dtype=jnp.float32) / half)
    ang = pos[:, None] * inv[None, :]
    cos = jnp.cos(ang)[None, :, None, :]
    sin = jnp.sin(ang)[None, :, None, :]
    x1, x2 = x[..., :half], x[..., half:]
    return jnp.concatenate([x1 * cos - x2 * sin, x1 * sin + x2 * cos], axis=-1)


def retention_chunkwise(q, k, v, log_gamma):
    B, S, H, dk = q.shape
    dv = v.shape[-1]
    C = RET_CHUNK
    n = S // C
    qc = q.reshape(B, n, C, H, dk)
    kc = k.reshape(B, n, C, H, dk)
    vc = v.reshape(B, n, C, H, dv)
    j = jnp.arange(C, dtype=jnp.float32)
    diff = j[:, None] - j[None, :]
    intra = jnp.where(diff[None] >= 0,
                      jnp.exp(jnp.maximum(diff, 0.0)[None] * log_gamma[:, None, None]),
                      0.0)
    scores = jnp.einsum('bnihd,bnjhd->bnhij', qc, kc) * intra[None, None]
    out_intra = jnp.einsum('bnhij,bnjhe->bnihe', scores, vc)
    q_decay = jnp.exp((j + 1.0)[:, None] * log_gamma[None, :])
    k_decay = jnp.exp((C - 1.0 - j)[:, None] * log_gamma[None, :])
    chunk_decay = jnp.exp(C * log_gamma)

    def step(state, xs):
        qi, ki, vi = xs
        out = jnp.einsum('bihd,bhde->bihe', qi * q_decay[None, :, :, None], state)
        state = state * chunk_decay[None, :, None, None] + jnp.einsum(
            'bihd,bihe->bhde', ki * k_decay[None, :, :, None], vi)
        return state, out

    state0 = jnp.zeros((B, H, dk, dv), jnp.float32)
    xs = (qc.transpose(1, 0, 2, 3, 4), kc.transpose(1, 0, 2, 3, 4), vc.transpose(1, 0, 2, 3, 4))
    _, out_cross = lax.scan(step, state0, xs)
    out = out_intra + out_cross.transpose(1, 0, 2, 3, 4)
    return out.reshape(B, S, H, dv)


def retention_mixer(h, w_in, w_out, gn_g, dec_fwd, dec_bwd):
    B, S, _ = h.shape
    proj = h @ w_in
    q, k, v, g = jnp.split(proj, [D_MODEL, 2 * D_MODEL, 2 * D_MODEL + RET_V_WIDTH], axis=-1)
    pos = jnp.arange(S, dtype=jnp.float32)
    q = rotary(q.astype(jnp.float32).reshape(B, S, RET_HEADS, RET_QK_DIM), pos)
    k = rotary(k.astype(jnp.float32).reshape(B, S, RET_HEADS, RET_QK_DIM), pos) * (RET_QK_DIM ** -0.5)
    v = v.astype(jnp.float32).reshape(B, S, RET_HEADS, RET_V_DIM)
    lg_f = jax.nn.log_sigmoid(dec_fwd.astype(jnp.float32))
    lg_b = jax.nn.log_sigmoid(dec_bwd.astype(jnp.float32))
    y_f = retention_chunkwise(q, k, v, lg_f)
    y_b = jnp.flip(retention_chunkwise(jnp.flip(q, 1), jnp.flip(k, 1), jnp.flip(v, 1), lg_b), 1)
    y = y_f + y_b
    mu = jnp.mean(y, axis=-1, keepdims=True)
    var = jnp.mean(jnp.square(y - mu), axis=-1, keepdims=True)
    y = ((y - mu) * lax.rsqrt(var + EPS)).reshape(B, S, RET_V_WIDTH) * gn_g.astype(jnp.float32)
    y = jax.nn.silu(g.astype(jnp.float32)) * y
    return y.astype(h.dtype) @ w_out


def fourier_mixer(h, w_f, b_f):
    B, S, D = h.shape
    hg = h.astype(jnp.float32).reshape(B, S, FNO_GROUPS, FNO_GROUP_DIM)
    mixed = jnp.fft.fft2(hg, axes=(1, 3)).real.reshape(B, S, D)
    return mixed.astype(h.dtype) @ w_f + b_f


def sq_relu_mlp(h, w1, w2):
    a = jax.nn.relu(h @ w1)
    return (a * a) @ w2


def setup_inputs(seed: int = 0) -> dict:
    key = jax.random.key(seed)
    ks = jax.random.split(key, 16)
    f32 = jnp.float32
    D = D_MODEL
    base_logit = np.log(2.0 ** (5.0 + np.arange(RET_HEADS)) - 1.0).astype(np.float32)
    return {
        "x": jax.random.normal(ks[0], (BATCH, SEQ, D), f32),
        "c": jax.random.normal(ks[1], (BATCH, D), f32),
        "ada_w": jax.random.normal(ks[2], (DEPTH, D, N_MOD * D), f32) * (0.5 * D ** -0.5),
        "ada_b": jax.random.normal(ks[3], (DEPTH, N_MOD * D), f32) * 0.02,
        "norm_g": 1.0 + 0.02 * jax.random.normal(ks[4], (DEPTH, 4, D), f32),
        "ret_w_in": jax.random.normal(ks[5], (N_RET_LAYERS, D, RET_IN_WIDTH), f32) * D ** -0.5,
        "ret_w_out": jax.random.normal(ks[6], (N_RET_LAYERS, RET_V_WIDTH, D), f32) * RET_V_WIDTH ** -0.5,
        "ret_gn_g": 1.0 + 0.02 * jax.random.normal(ks[7], (N_RET_LAYERS, RET_V_WIDTH), f32),
        "ret_decay_fwd": jnp.asarray(base_logit)[None, :] + 0.1 * jax.random.normal(ks[8], (N_RET_LAYERS, RET_HEADS), f32),
        "ret_decay_bwd": jnp.asarray(base_logit[::-1].copy())[None, :] + 0.1 * jax.random.normal(ks[9], (N_RET_LAYERS, RET_HEADS), f32),
        "fno_w": jax.random.normal(ks[10], (N_FNO_LAYERS, D, D), f32) * D ** -0.5,
        "fno_b": jax.random.normal(ks[11], (N_FNO_LAYERS, D), f32) * 0.02,
        "mlp_w1": jax.random.normal(ks[12], (DEPTH, D, D_FF), f32) * D ** -0.5,
        "mlp_w2": jax.random.normal(ks[13], (DEPTH, D_FF, D), f32) * D_FF ** -0.5,
    }


def reference(x, c, ada_w, ada_b, norm_g, ret_w_in, ret_w_out, ret_gn_g,
              ret_decay_fwd, ret_decay_bwd, fno_w, fno_b, mlp_w1, mlp_w2):
    for layer in range(DEPTH):
        occ = layer // N_MIXERS
        sh1, sc1, g1, sh2, sc2, g2 = adaln_params(c, ada_w[layer], ada_b[layer])
        h = rms_norm(x, norm_g[layer, 0]) * (1.0 + sc1) + sh1
        if layer % N_MIXERS == 0:
            y = retention_mixer(h, ret_w_in[occ], ret_w_out[occ], ret_gn_g[occ],
                                ret_decay_fwd[occ], ret_decay_bwd[occ])
        else:
            y = fourier_mixer(h, fno_w[occ], fno_b[occ])
        x = x + g1 * rms_norm(y, norm_g[layer, 1])
        h = rms_norm(x, norm_g[layer, 2]) * (1.0 + sc2) + sh2
        x = x + g2 * rms_norm(sq_relu_mlp(h, mlp_w1[layer], mlp_w2[layer]), norm_g[layer, 3])
    return x
```

```cpp
#include <hip/hip_runtime.h>
#include <cstdio>
#include <cstdint>

#ifndef MK_SINGLE
#define MK_SINGLE 1
#endif

namespace pg8 {
#define PG8_LAS __attribute__((address_space(3)))
typedef unsigned short bf16_t;
typedef short bf16x8 __attribute__((ext_vector_type(8)));
typedef float f32x4 __attribute__((ext_vector_type(4)));
typedef unsigned u32x4 __attribute__((ext_vector_type(4)));
constexpr int BM = 256, BK = 64, HALF = 128, HTB = HALF * BK * 2  , STAGE_BYTES = 8 * HTB, NXCD = 8, WGM = 8;

__host__ __device__ __forceinline__ int lds_byte(int r, int c) { const int st = (r >> 4) * 2 + (c >> 5), rr = r & 15, cc = c & 31, ob = rr * 64 + cc * 2; return st * 1024 + (ob ^ (((ob >> 9) & 1) << 5)); }
__host__ __device__ __forceinline__ void stage_rc(int b, int& R, int& C) { const int st = b / 1024, sb = b % 1024, swz = sb ^ (((sb >> 9) & 1) << 5); R = (st >> 1) * 16 + swz / 64; C = (st & 1) * 32 + (swz % 64) / 2; }
__host__ __device__ __forceinline__ int perm32(int rho) { const int n = rho >> 4, i = rho & 15; return 8 * (i >> 2) + 4 * n + (i & 3); }

struct Unit { int pm, pn, z; };
struct Gemm { const bf16_t* A; const bf16_t* Bt; int lda, ldb, K; size_t zA, zB; };

struct StaticOrder {
    int nM, nN, nwg, G, c;
    __host__ __device__ void init(int M, int N, int G_, int c_) { nM = M / BM; nN = N / BM; nwg = nM * nN; G = G_; c = c_; }
    __host__ __device__ bool next(int i, Unit& u) const {
        const long L = (long)i * G + c; if (L >= nwg) return false;
        int wgid = (int)L; { const int q = nwg / NXCD, r = nwg % NXCD, xcd = wgid % NXCD, off = wgid / NXCD; wgid = (xcd < r ? xcd * (q + 1) : r * (q + 1) + (xcd - r) * q) + off; }
        const int nig = WGM * nN, gid = wgid / nig, fm = gid * WGM, gsz = (nM - fm) < WGM ? (nM - fm) : WGM;
        u.pm = fm + ((wgid % nig) % gsz); u.pn = (wgid % nig) / gsz; u.z = 0; return true;
    }
    __device__ __forceinline__ void a_ready(const Unit&) const {}
    __device__ __forceinline__ void done(const Unit&) const {}
};
struct BatchOrder {
    int nM, nN, nz, nwg, G, c;
    __host__ __device__ void init(int M, int N, int nz_, int G_, int c_) { nM = M / BM; nN = N / BM; nz = nz_; nwg = nM * nN * nz; G = G_; c = c_; }
    __host__ __device__ bool next(int i, Unit& u) const {
        const long L = (long)i * G + c; if (L >= nwg) return false;
        const int per = nM * nN, l = (int)L; u.z = l / per; const int r = l % per; u.pn = r / nM; u.pm = r % nM; return true;
    }
    __device__ __forceinline__ void a_ready(const Unit&) const {}
    __device__ __forceinline__ void done(const Unit&) const {}
};

__device__ __forceinline__ unsigned cvt_pk_bf16(float lo, float hi) { unsigned r; asm volatile("v_cvt_pk_bf16_f32 %0, %1, %2" : "=v"(r) : "v"(lo), "v"(hi)); return r; }
__device__ __forceinline__ u32x4 pack8(const f32x4 v0, const f32x4 v1) { u32x4 w; w.x = cvt_pk_bf16(v0[0], v0[1]); w.y = cvt_pk_bf16(v0[2], v0[3]); w.z = cvt_pk_bf16(v1[0], v1[1]); w.w = cvt_pk_bf16(v1[2], v1[3]); return w; }
__device__ __forceinline__ bf16_t f2bf1(float f) { return (bf16_t)(cvt_pk_bf16(f, f) & 0xffffu); }

template <int ACT> struct EpiBf16 {
    static constexpr bool PERM = true, AFTER_DRAIN = false;
    bf16_t* O; int ldc; const float* bias;
    __device__ __forceinline__ void operator()(const f32x4 (&acc)[2][2][4][2], const Unit& u, int wr, int wc, int fr, int fq) const {
        const int row0 = u.pm * BM + wr * 64 + fr; const int col0 = u.pn * BM + wc * 32 + 8 * fq;
        f32x4 bv[2][2];
#pragma unroll
        for (int bj = 0; bj < 2; ++bj)
#pragma unroll
            for (int n = 0; n < 2; ++n) bv[bj][n] = bias ? *(const f32x4*)(bias + col0 + bj * HALF + 4 * n) : (f32x4){0.f, 0.f, 0.f, 0.f};
#pragma unroll
        for (int ai = 0; ai < 2; ++ai)
#pragma unroll
            for (int m = 0; m < 4; ++m) { bf16_t* rowp = O + (size_t)(row0 + ai * HALF + m * 16) * ldc + col0;
#pragma unroll
                for (int bj = 0; bj < 2; ++bj) { f32x4 v0 = acc[ai][bj][m][0] + bv[bj][0], v1 = acc[ai][bj][m][1] + bv[bj][1];
                    if (ACT == 1) {
#pragma unroll
                        for (int e = 0; e < 4; ++e) { const float a = fmaxf(v0[e], 0.f), b = fmaxf(v1[e], 0.f); v0[e] = a * a; v1[e] = b * b; } }
                    *(u32x4*)(rowp + bj * HALF) = pack8(v0, v1); } }
    }
};
struct EpiFft1 {
    static constexpr bool PERM = true, AFTER_DRAIN = false;
    bf16_t* O;
    __device__ __forceinline__ void operator()(const f32x4 (&acc)[2][2][4][2], const Unit& u, int wr, int wc, int fr, int fq) const {
        const int r0 = (u.pm & 1) * BM + wr * 64 + fr, cs = u.pm >> 1; const int col0 = u.pn * BM + wc * 32 + 8 * fq;
#pragma unroll
        for (int ai = 0; ai < 2; ++ai)
#pragma unroll
            for (int m = 0; m < 4; ++m) { bf16_t* rowp = O + ((size_t)(u.z * 512 + r0 + ai * HALF + m * 16) * 2 + cs) * 8192 + col0;
#pragma unroll
                for (int bj = 0; bj < 2; ++bj) *(u32x4*)(rowp + bj * HALF) = pack8(acc[ai][bj][m][0], acc[ai][bj][m][1]); }
    }
};
struct EpiMixB {
    static constexpr bool PERM = true, AFTER_DRAIN = false;
    bf16_t* O;
    __device__ __forceinline__ void operator()(const f32x4 (&acc)[2][2][4][2], const Unit& u, int wr, int wc, int fr, int fq) const {
        const int r0 = wr * 64 + fr; const int col0 = u.pn * BM + wc * 32 + 8 * fq;
#pragma unroll
        for (int ai = 0; ai < 2; ++ai)
#pragma unroll
            for (int m = 0; m < 4; ++m) { bf16_t* rowp = O + (size_t)(32 * (r0 + ai * HALF + m * 16) + u.z) * 4096 + col0;
#pragma unroll
                for (int bj = 0; bj < 2; ++bj) *(u32x4*)(rowp + bj * HALF) = pack8(acc[ai][bj][m][0], acc[ai][bj][m][1]); }
    }
};
constexpr int RC = 256;
__device__ __forceinline__ float lg2_sigmoid(float d) { return -log1pf(__expf(-d)) * 1.44269504089f; }
__device__ __forceinline__ size_t off_qt(int h, int t, int dk) { return ((((size_t)(h * 256 + (t >> 5)) * 16 + (dk >> 4)) * 2 + ((dk >> 3) & 1)) * 32 + (t & 31)) * 8 + (dk & 7); }
__device__ __forceinline__ void tr_store16(PG8_LAS unsigned char* sw, int fr, int fq, const f32x4 (&v)[2][2], float scale, bf16_t* tile0, int ndim) {
    PG8_LAS bf16_t* wp = (PG8_LAS bf16_t*)(sw + ((fr >> 2) & 1) * 16 + (4 * (fr >> 3) + (fr & 3)) * 2);
#pragma unroll
    for (int bj = 0; bj < 2; ++bj)
#pragma unroll
        for (int n = 0; n < 2; ++n)
#pragma unroll
            for (int e = 0; e < 4; ++e) wp[(bj * 32 + fq * 8 + n * 4 + e) * 16] = f2bf1(v[bj][n][e] * scale);
    asm volatile("" ::: "memory");
    const int lane = fq * 16 + fr;
#pragma unroll
    for (int k = 0; k < 2; ++k) { const int q = lane + 64 * k, col = q >> 1, hq = q & 1;
        const u32x4 val = *(const PG8_LAS u32x4*)(sw + q * 16);
        *(u32x4*)(tile0 + ((size_t)hq * ndim + (col >> 5) * 128 + (col & 31)) * 8) = val; }
    asm volatile("" ::: "memory");
}
struct EpiWin {
    static constexpr bool PERM = true, AFTER_DRAIN = false;
    bf16_t *Q0, *K0, *KFT, *KBT, *VT, *SG; const float* decf; const float* decb; int S; PG8_LAS unsigned char* scr;
    __device__ __forceinline__ void operator()(const f32x4 (&acc)[2][2][4][2], const Unit& u, int wr, int wc, int fr, int fq) const {
        const int pn = u.pn; const int rowb = u.pm * BM + wr * 64 + fr; const int cj = wc * 32 + fq * 8;
        PG8_LAS unsigned char* sw = scr + (wr * 4 + wc) * 2048;
        if (pn < 32) {
            const bool isk = pn >= 16; const int h = pn & 15;
            const float lf2 = lg2_sigmoid(decf[h]), lb2 = lg2_sigmoid(decb[h]);
            float inv[8];
#pragma unroll
            for (int e = 0; e < 8; ++e) inv[e] = __builtin_amdgcn_exp2f(-(float)(cj + e) * (13.287712379549449f / 128.f));
#pragma unroll
            for (int ai = 0; ai < 2; ++ai)
#pragma unroll
                for (int m = 0; m < 4; ++m) {
                    const int row = rowb + ai * HALF + m * 16;
                    f32x4 c0, c1, s0, s1;
#pragma unroll
                    for (int e = 0; e < 4; ++e) {
                        const float r0 = __builtin_amdgcn_fractf(((float)row * inv[e]) * 0.15915494309189535f), r1 = __builtin_amdgcn_fractf(((float)row * inv[4 + e]) * 0.15915494309189535f);
                        c0[e] = __builtin_amdgcn_cosf(r0); s0[e] = __builtin_amdgcn_sinf(r0); c1[e] = __builtin_amdgcn_cosf(r1); s1[e] = __builtin_amdgcn_sinf(r1); }
                    const f32x4 x1a = acc[ai][0][m][0], x1b = acc[ai][0][m][1], x2a = acc[ai][1][m][0], x2b = acc[ai][1][m][1];
                    f32x4 o1a = x1a * c0 - x2a * s0, o1b = x1b * c1 - x2b * s1, o2a = x1a * s0 + x2a * c0, o2b = x1b * s1 + x2b * c1;
                    const int jj = row & (RC - 1);
                    const size_t o1 = off_qt(h, row, cj), o2 = off_qt(h, row, 128 + cj);
                    if (!isk) {
                        *(u32x4*)(Q0 + o1) = pack8(o1a, o1b); *(u32x4*)(Q0 + o2) = pack8(o2a, o2b);
                    } else {
                        o1a = o1a * 0.0625f; o1b = o1b * 0.0625f; o2a = o2a * 0.0625f; o2b = o2b * 0.0625f;
                        *(u32x4*)(K0 + o1) = pack8(o1a, o1b); *(u32x4*)(K0 + o2) = pack8(o2a, o2b);
                        const float f = __builtin_amdgcn_exp2f((float)(RC - 1 - jj) * lf2), b = __builtin_amdgcn_exp2f((float)jj * lb2);
                        const int row0 = row - fr;
                        const size_t tb = ((((size_t)(h * 256 + (row0 >> 5)) * 2 + ((row0 >> 4) & 1)) * 2) * 256 + wc * 32) * 8;
                        const f32x4 ov[2][2] = {{o1a, o1b}, {o2a, o2b}};
                        tr_store16(sw, fr, fq, ov, f, KFT + tb, 256);
                        tr_store16(sw, fr, fq, ov, b, KBT + tb, 256);
                    }
                }
        } else if (pn < 64) {
            const int h = (pn - 32) >> 1, dv0 = ((pn - 32) & 1) * 256 + wc * 32;
#pragma unroll
            for (int ai = 0; ai < 2; ++ai)
#pragma unroll
                for (int m = 0; m < 4; ++m) { const int row0 = rowb - fr + ai * HALF + m * 16;
                    const f32x4 ov[2][2] = {{acc[ai][0][m][0], acc[ai][0][m][1]}, {acc[ai][1][m][0], acc[ai][1][m][1]}};
                    tr_store16(sw, fr, fq, ov, 1.0f, VT + ((((size_t)(h * 256 + (row0 >> 5)) * 2 + ((row0 >> 4) & 1)) * 2) * 512 + dv0) * 8, 512); }
        } else {
            const int cb = (pn - 64) * 256 + cj;
#pragma unroll
            for (int ai = 0; ai < 2; ++ai)
#pragma unroll
                for (int m = 0; m < 4; ++m) { bf16_t* rowp = SG + (size_t)(rowb + ai * HALF + m * 16) * 8192 + cb;
#pragma unroll
                    for (int bj = 0; bj < 2; ++bj) { f32x4 v0 = acc[ai][bj][m][0], v1 = acc[ai][bj][m][1];
#pragma unroll
                        for (int e = 0; e < 4; ++e) { v0[e] = v0[e] * __builtin_amdgcn_rcpf(1.f + __expf(-v0[e])); v1[e] = v1[e] * __builtin_amdgcn_rcpf(1.f + __expf(-v1[e])); }
                        *(u32x4*)(rowp + bj * HALF) = pack8(v0, v1); } }
        }
    }
};

template <class Epi, class Sched, bool ALIGN_EPI = false, bool SP2 = false, bool KFIX = false>
__device__ __forceinline__ void gemm_phase(PG8_LAS unsigned char* lds, const Gemm g, const Sched& S, const Epi& E) {
    const int tid = threadIdx.x, wid = __builtin_amdgcn_readfirstlane(tid >> 6), lane = tid & 63, wr = wid >> 2, wc = wid & 3, fr = lane & 15, fq = lane >> 4;
    const int K = g.K, nt = K / BK;
    unsigned voffA[2], voffB[2];
#pragma unroll
    for (int i = 0; i < 2; ++i) { int R, C; stage_rc(tid * 16 + i * 8192, R, C); const int Rb = Epi::PERM ? ((R & ~31) + perm32(R & 31)) : R;
        voffA[i] = (unsigned)(R * g.lda + C) * 2u; voffB[i] = (unsigned)(Rb * g.ldb + C) * 2u; }
    const size_t kstep = KFIX ? (size_t)0 : (size_t)(BK * 2);
    const size_t hstepA = (size_t)HALF * g.lda * 2, hstepB = (size_t)HALF * g.ldb * 2;
    const size_t tstepA = 2 * hstepA, tstepB = 2 * hstepB;
    const unsigned ldsw = (unsigned)wid * 1024u;
    const int aoff = lds_byte(wr * 64 + fr, fq * 8), boff = lds_byte(wc * 32 + fr, fq * 8);
#define PG8_SA(b, h) (((b) * 2 + (h)) * HTB)
#define PG8_SB(b, h) ((4 + (b) * 2 + (h)) * HTB)
#define PG8_STAGE(bufoff, gbase, voff) do { _Pragma("unroll") for (int _i = 0; _i < 2; ++_i) \
        __builtin_amdgcn_global_load_lds((const unsigned*)((const char*)(gbase) + (voff)[_i]), (PG8_LAS unsigned*)(lds + (bufoff) + ldsw + _i * 8192), 16, 0, 0); } while (0)
#define PG8_LDA(dst, b, h) do { _Pragma("unroll") for (int m = 0; m < 4; ++m) _Pragma("unroll") for (int k = 0; k < 2; ++k) dst[m][k] = *(const PG8_LAS bf16x8*)(lds + PG8_SA(b, h) + aoff + m * 2048 + k * 1024); } while (0)
#define PG8_LDB(dst, b, h) do { _Pragma("unroll") for (int n = 0; n < 2; ++n) _Pragma("unroll") for (int k = 0; k < 2; ++k) dst[n][k] = *(const PG8_LAS bf16x8*)(lds + PG8_SB(b, h) + boff + n * 2048 + k * 1024); } while (0)
#define PG8_MMA(ai, bj, At, Bt) do { __builtin_amdgcn_s_setprio(1); _Pragma("unroll") for (int k = 0; k < 2; ++k) _Pragma("unroll") for (int m = 0; m < 4; ++m) _Pragma("unroll") for (int nn = 0; nn < 2; ++nn) { const int n = nn ^ (m & 1); \
        acc[ai][bj][m][n] = __builtin_amdgcn_mfma_f32_16x16x32_bf16(Bt[n][k], At[m][k], acc[ai][bj][m][n], 0, 0, 0); } __builtin_amdgcn_s_setprio(0); } while (0)
#define PG8_WAIT_V(n) asm volatile("s_waitcnt vmcnt(" #n ")" ::: "memory")
#define PG8_WAIT_L(n) asm volatile("s_waitcnt lgkmcnt(" #n ")" ::: "memory")
#define PG8_BAR __builtin_amdgcn_s_barrier()
#define PG8_SCHED __builtin_amdgcn_sched_barrier(0)
    Unit cur, nxt; int ui = 0;
    if (!S.next(0, cur)) return;
    f32x4 acc[2][2][4][2];
#pragma unroll
    for (int a = 0; a < 2; ++a)
#pragma unroll
        for (int b = 0; b < 2; ++b)
#pragma unroll
            for (int m = 0; m < 4; ++m)
#pragma unroll
                for (int n = 0; n < 2; ++n) acc[a][b][m][n] = (f32x4){0.f, 0.f, 0.f, 0.f};
    bf16x8 At[4][2], B0[2][2], B1[2][2];
    const char* cA = (const char*)(g.A + (size_t)cur.z * g.zA) + (size_t)cur.pm * tstepA; const char* cB = (const char*)(g.Bt + (size_t)cur.z * g.zB) + (size_t)cur.pn * tstepB;
    S.a_ready(cur);
    if constexpr (SP2) {
        PG8_STAGE(PG8_SB(0, 0), cB, voffB); PG8_STAGE(PG8_SB(0, 1), cB + hstepB, voffB); PG8_STAGE(PG8_SA(0, 0), cA, voffA); PG8_STAGE(PG8_SA(0, 1), cA + hstepA, voffA);
        if (wr == 1) PG8_BAR;
        PG8_WAIT_V(2); PG8_BAR;
        PG8_STAGE(PG8_SB(1, 0), cB + kstep, voffB); PG8_STAGE(PG8_SA(1, 0), cA + kstep, voffA); PG8_STAGE(PG8_SB(1, 1), cB + hstepB + kstep, voffB);
        PG8_WAIT_V(6); PG8_BAR;
    } else {
        PG8_STAGE(PG8_SB(0, 0), cB, voffB); PG8_STAGE(PG8_SA(0, 0), cA, voffA); PG8_STAGE(PG8_SB(0, 1), cB + hstepB, voffB); PG8_STAGE(PG8_SA(0, 1), cA + hstepA, voffA);
        if (wr == 1) PG8_BAR;
        PG8_WAIT_V(4); PG8_BAR;
        PG8_STAGE(PG8_SB(1, 0), cB + kstep, voffB); PG8_STAGE(PG8_SA(1, 0), cA + kstep, voffA); PG8_STAGE(PG8_SB(1, 1), cB + hstepB + kstep, voffB);
        PG8_WAIT_V(6); PG8_BAR;
    }
    for (;;) {
        const bool has_next = S.next(ui + 1, nxt);
        const char* nA = has_next ? (const char*)(g.A + (size_t)nxt.z * g.zA) + (size_t)nxt.pm * tstepA : cA; const char* nB = has_next ? (const char*)(g.Bt + (size_t)nxt.z * g.zB) + (size_t)nxt.pn * tstepB : cB;
        for (int t = 0; t < nt; t += 2) {
            const bool last = (t == nt - 2);
            const char* a1 = cA + (size_t)(t + 1) * kstep;
            const char* a2 = last ? nA : cA + (size_t)(t + 2) * kstep; const char* b2 = last ? nB : cB + (size_t)(t + 2) * kstep;
            const char* a3 = a2 + kstep; const char* b3 = b2 + kstep;
            if (last && has_next) S.a_ready(nxt);
            if constexpr (SP2) {
            PG8_LDB(B0, 0, 0); PG8_LDB(B1, 0, 1); PG8_SCHED; PG8_LDA(At, 0, 0); PG8_STAGE(PG8_SA(1, 1), a1 + hstepA, voffA);
            PG8_WAIT_V(8); PG8_WAIT_L(0); PG8_BAR; PG8_MMA(0, 0, At, B0); PG8_MMA(0, 1, At, B1); PG8_BAR; PG8_SCHED;
            PG8_LDA(At, 0, 1); PG8_STAGE(PG8_SB(0, 0), b2, voffB); PG8_STAGE(PG8_SB(0, 1), b2 + hstepB, voffB); PG8_STAGE(PG8_SA(0, 0), a2, voffA);
            PG8_WAIT_V(8); PG8_WAIT_L(0); PG8_BAR; PG8_MMA(1, 0, At, B0); PG8_MMA(1, 1, At, B1); PG8_BAR; PG8_SCHED;
            PG8_LDB(B0, 1, 0); PG8_LDB(B1, 1, 1); PG8_SCHED; PG8_LDA(At, 1, 0); PG8_STAGE(PG8_SA(0, 1), a2 + hstepA, voffA);
            PG8_WAIT_V(8); PG8_WAIT_L(0); PG8_BAR; PG8_MMA(0, 0, At, B0); PG8_MMA(0, 1, At, B1); PG8_BAR; PG8_SCHED;
            PG8_LDA(At, 1, 1); PG8_STAGE(PG8_SB(1, 0), b3, voffB); PG8_STAGE(PG8_SB(1, 1), b3 + hstepB, voffB); PG8_STAGE(PG8_SA(1, 0), a3, voffA);
            PG8_WAIT_V(8); PG8_WAIT_L(0); PG8_BAR; PG8_MMA(1, 0, At, B0); PG8_MMA(1, 1, At, B1); PG8_BAR; PG8_SCHED;
            } else {
            PG8_LDB(B0, 0, 0); PG8_SCHED; PG8_LDA(At, 0, 0); PG8_STAGE(PG8_SA(1, 1), a1 + hstepA, voffA);
            PG8_WAIT_L(8); PG8_BAR; PG8_WAIT_L(0); PG8_MMA(0, 0, At, B0); PG8_BAR; PG8_SCHED;
            PG8_LDB(B1, 0, 1); PG8_STAGE(PG8_SB(0, 0), b2, voffB);
            PG8_BAR; PG8_WAIT_L(0); PG8_MMA(0, 1, At, B1); PG8_BAR;
            PG8_LDA(At, 0, 1); PG8_STAGE(PG8_SA(0, 0), a2, voffA);
            PG8_BAR; PG8_WAIT_L(0); PG8_MMA(1, 0, At, B0); PG8_BAR; PG8_SCHED;
            PG8_STAGE(PG8_SB(0, 1), b2 + hstepB, voffB);
            PG8_WAIT_V(6); PG8_BAR; PG8_MMA(1, 1, At, B1); PG8_BAR;
            PG8_LDB(B0, 1, 0); PG8_SCHED; PG8_LDA(At, 1, 0); PG8_STAGE(PG8_SA(0, 1), a2 + hstepA, voffA);
            PG8_WAIT_L(8); PG8_BAR; PG8_WAIT_L(0); PG8_MMA(0, 0, At, B0); PG8_BAR; PG8_SCHED;
            PG8_LDB(B1, 1, 1); PG8_STAGE(PG8_SB(1, 0), b3, voffB);
            PG8_BAR; PG8_WAIT_L(0); PG8_MMA(0, 1, At, B1); PG8_BAR;
            PG8_LDA(At, 1, 1); PG8_STAGE(PG8_SA(1, 0), a3, voffA);
            PG8_BAR; PG8_WAIT_L(0); PG8_MMA(1, 0, At, B0); PG8_BAR; PG8_SCHED;
            PG8_STAGE(PG8_SB(1, 1), b3 + hstepB, voffB);
            PG8_WAIT_V(6); PG8_BAR; PG8_MMA(1, 1, At, B1); PG8_BAR;
            }
        }
        if constexpr (ALIGN_EPI) { if (wr == 0) PG8_BAR; }
        E(acc, cur, wr, wc, fr, fq); S.done(cur);
        if (!has_next) break;
#pragma unroll
        for (int a = 0; a < 2; ++a)
#pragma unroll
            for (int b = 0; b < 2; ++b)
#pragma unroll
                for (int m = 0; m < 4; ++m)
#pragma unroll
                    for (int n = 0; n < 2; ++n) acc[a][b][m][n] = (f32x4){0.f, 0.f, 0.f, 0.f};
        cur = nxt; cA = nA; cB = nB; ++ui;
        if constexpr (ALIGN_EPI) { if (wr == 1) PG8_BAR; }
    }
    PG8_WAIT_V(0);
    if constexpr (!ALIGN_EPI) { if (wr == 0) PG8_BAR; }
    PG8_BAR;
#undef PG8_SA
#undef PG8_SB
#undef PG8_STAGE
#undef PG8_LDA
#undef PG8_LDB
#undef PG8_MMA
#undef PG8_WAIT_V
#undef PG8_WAIT_L
#undef PG8_BAR
#undef PG8_SCHED
}
}

#ifndef PG8_SP2
#define PG8_SP2 true
#endif
#ifndef PG8_ALIGN
#define PG8_ALIGN true
#endif

constexpr int NWAVES = 8;
constexpr int S_ = 8192, D_ = 4096, H_ = 16, DK = 256, DV = 512, VW = 8192, WIN = 24576, DFF = 16384, NMOD = 6 * D_;
constexpr int NCH = S_ / pg8::RC;
constexpr float EPS_ = 1e-6f;

constexpr size_t MiB = 1u << 20;
constexpr size_t WS_CTL = 0, CTL_ZERO_BYTES = 1 * MiB;
constexpr size_t WS_MOD = 1 * MiB;
constexpr size_t WS_T512 = 2 * MiB;
constexpr size_t WS_WIN = 16 * MiB;
constexpr size_t WS_WOUT = 208 * MiB;
constexpr size_t WS_WF = 272 * MiB;
constexpr size_t WS_W1 = 304 * MiB;
constexpr size_t WS_W2 = 560 * MiB;
constexpr size_t WS_G = 816 * MiB;
constexpr size_t WS_AB = 944 * MiB;
constexpr size_t WS_XN = 1072 * MiB;
constexpr size_t WS_XA = 1136 * MiB;
constexpr size_t WS_Y = 1264 * MiB;
constexpr size_t WS_Q0 = 1328 * MiB, WS_K0 = 1520 * MiB, WS_KFT = 1584 * MiB, WS_KBT = 1648 * MiB;
constexpr size_t WS_VT = 1712 * MiB;
constexpr size_t WS_SG = 1840 * MiB;
constexpr size_t WS_ST = 1968 * MiB;
constexpr size_t WS_A2 = 2224 * MiB;
constexpr size_t WS_HB = WS_Q0;
constexpr size_t WS_YT = WS_KFT;
constexpr size_t WS_MIX = WS_VT;
constexpr size_t WS_END = 2352 * MiB;
static_assert(WS_ST + (size_t)H_ * NCH * 2 * DV * DK * 2 <= WS_A2, "ST fits");
constexpr int CW_TMO = 0, CW_Q = 64;
constexpr int CW_BAR = 4096;
constexpr int RING_OFF = 0, RING_BYTES = 131072;
constexpr int LDSCTL_OFF = 155648, MISC_OFF = LDSCTL_OFF + 320;
constexpr int LDS_BYTES = 163840;

#define GAS __attribute__((address_space(1)))
#define LAS __attribute__((address_space(3)))
typedef unsigned short bf16;
typedef unsigned v4u __attribute__((ext_vector_type(4)));
typedef unsigned v2u __attribute__((ext_vector_type(2)));
typedef float f32x4 __attribute__((ext_vector_type(4)));
typedef float f32x16 __attribute__((ext_vector_type(16)));
typedef short bf16x8 __attribute__((ext_vector_type(8)));
typedef short bf16x4 __attribute__((ext_vector_type(4)));
typedef GAS unsigned gu32;
#define RLX_AGENT __ATOMIC_RELAXED, __HIP_MEMORY_SCOPE_AGENT
#define LDS_WAIT() asm volatile("s_waitcnt lgkmcnt(0)" ::: "memory")
#define VM_WAIT() asm volatile("s_waitcnt vmcnt(0)" ::: "memory")
__device__ __forceinline__ unsigned pk2(float lo, float hi) { return pg8::cvt_pk_bf16(lo, hi); }
__device__ __forceinline__ float bf_lo(unsigned w) { return __builtin_bit_cast(float, w << 16); }
__device__ __forceinline__ float bf_hi(unsigned w) { return __builtin_bit_cast(float, w & 0xffff0000u); }

#define XB_TMO      128
#define XB_XCNT(j)  (256  + 64 * (j))
#define XB_XSUB(j)  (1280 + 64 * (j))
#define XB_XGEN(j)  (2304 + 64 * (j))
#define XB_TOP      3328
#define XB_TOPGEN   3392
#define XCD_BAR_WORDS 3456
#define XB_SPIN_CAP (1u << 18)
__device__ __forceinline__ unsigned xb_ld(unsigned* p)              { return __hip_atomic_load(p, __ATOMIC_RELAXED, __HIP_MEMORY_SCOPE_AGENT); }
__device__ __forceinline__ unsigned xb_add(unsigned* p, unsigned v) { return __hip_atomic_fetch_add(p, v, __ATOMIC_RELAXED, __HIP_MEMORY_SCOPE_AGENT); }
__device__ __forceinline__ unsigned xb_xcc_id() { return (unsigned)__builtin_amdgcn_s_getreg((3 << 11) | 20) & 0xFu; }
#define XB_SPIN(cond, bar) do { unsigned _sp = 0; while (cond) { __builtin_amdgcn_s_sleep(1); \
    if ((++_sp & 255u) == 0u) { if (xb_ld(&(bar)[XB_TMO])) break; if (_sp > XB_SPIN_CAP) { atomicAdd(&(bar)[XB_TMO], 1u); break; } } } } while (0)
struct XcdBarrier { unsigned* bar; unsigned x; volatile LAS unsigned* st; };
__device__ __forceinline__ XcdBarrier xcd_barrier_post(unsigned* bar, volatile LAS unsigned* st) {
    XcdBarrier b; b.bar = bar; b.x = xb_xcc_id(); b.st = st;
    if (threadIdx.x == 0) (void)xb_add(&bar[XB_XCNT(b.x)], 1u);
    return b;
}
__device__ __forceinline__ void xcd_barrier_complete(unsigned* bar, unsigned x, unsigned& nloc, unsigned& nx) {
    const unsigned G = gridDim.x * gridDim.y * gridDim.z;
    unsigned sum, cnt, mine, sp = 0u;
    for (;;) {
        sum = 0u; cnt = 0u; mine = 0u;
#pragma unroll
        for (unsigned j = 0; j < 16; ++j) { const unsigned c = xb_ld(&bar[XB_XCNT(j)]); sum += c; cnt += (c > 0u) ? 1u : 0u; mine = (j == x) ? c : mine; }
        if (sum == G) break;
        __builtin_amdgcn_s_sleep(1);
        if ((++sp & 255u) == 0u) { if (xb_ld(&bar[XB_TMO])) break; if (sp > XB_SPIN_CAP) { atomicAdd(&bar[XB_TMO], 1u); break; } }
    }
    nloc = mine > 0u ? mine : 1u; nx = cnt > 0u ? cnt : 1u;
}
__device__ __forceinline__ void xcd_barrier(const XcdBarrier& b) {
    asm volatile("s_waitcnt vmcnt(0)" ::: "memory");
    __syncthreads();
    if (threadIdx.x == 0) {
        unsigned* bar = b.bar;
        __builtin_amdgcn_s_waitcnt(0);
        unsigned nloc = b.st[0], nx = b.st[1];
        if (nloc == 0u) { xcd_barrier_complete(bar, b.x, nloc, nx); b.st[0] = nloc; b.st[1] = nx; }
        const unsigned old = xb_add(&bar[XB_XSUB(b.x)], 1u);
        const unsigned gen = old / nloc;
        if (old + 1u == (gen + 1u) * nloc) {
            __builtin_amdgcn_fence(__ATOMIC_RELEASE, "agent");
            asm volatile("s_waitcnt vmcnt(0)" ::: "memory");
            const unsigned og = xb_add(&bar[XB_TOP], 1u);
            const unsigned tg = og / nx;
            if (og + 1u == (tg + 1u) * nx) xb_add(&bar[XB_TOPGEN], 1u);
            else XB_SPIN(xb_ld(&bar[XB_TOPGEN]) == tg, bar);
            __builtin_amdgcn_fence(__ATOMIC_ACQUIRE, "agent");
            xb_add(&bar[XB_XGEN(b.x)], 1u);
            asm volatile("s_waitcnt vmcnt(0)" ::: "memory");
        } else {
            XB_SPIN(xb_ld(&bar[XB_XGEN(b.x)]) == gen, bar);
            __builtin_amdgcn_fence(__ATOMIC_ACQUIRE, "agent");
            asm volatile("s_waitcnt vmcnt(0)" ::: "memory");
        }
    }
    __syncthreads();
}

struct Args { const float* in[14]; float* out; unsigned char* ws; int ph_lo, ph_hi, li, pad; };
struct Frame {
    LAS unsigned char* lds; volatile LAS unsigned* MISC; unsigned* ctl;
    int tid, wave, G, bid;
    const float *x, *c, *ada_w, *ada_b, *norm_g, *w_in, *w_out, *gn_g, *decf, *decb, *fno_w, *fno_b, *w1, *w2; float* out;
    unsigned char* ws;
};
__device__ __forceinline__ float wave_sum(float v) {
#pragma unroll
    for (int o = 1; o < 64; o <<= 1) v += __shfl_xor(v, o);
    return v;
}

struct TrSub { float v[32]; };
__device__ __forceinline__ void tr_load(TrSub& t, const float* W, int N, int k0, int n0, int lane) {
    const float* p = W + (size_t)(k0 + (lane >> 5)) * N + n0 + (lane & 31);
#pragma unroll
    for (int i = 0; i < 32; ++i) t.v[i] = __builtin_nontemporal_load(p + (size_t)(2 * i) * N);
}
__device__ __forceinline__ void tr_store(const TrSub& t, int K, bf16* WT, int k0, int n0, LAS float* scr, int lane) {
#pragma unroll
    for (int i = 0; i < 32; ++i) scr[(2 * i + (lane >> 5)) * 33 + (lane & 31)] = t.v[i];
    LDS_WAIT(); asm volatile("" ::: "memory");
    const int c = lane & 7;
#pragma unroll
    for (int j = 0; j < 4; ++j) { const int n = (lane >> 3) + 8 * j; const LAS float* s = scr + (8 * c) * 33 + n;
        v4u o; o.x = pk2(s[0 * 33], s[1 * 33]); o.y = pk2(s[2 * 33], s[3 * 33]); o.z = pk2(s[4 * 33], s[5 * 33]); o.w = pk2(s[6 * 33], s[7 * 33]);
        *(GAS v4u*)(WT + (size_t)(n0 + n) * K + k0 + 8 * c) = o; }
    LDS_WAIT(); asm volatile("" ::: "memory");
}
__device__ __forceinline__ void tr_item(const float* W, bf16* WT, int K, int N, int it, LAS float* scr, int wave, int lane) {
    const int nb = N / 256, k0 = (it / nb) * 256, nn = (it % nb) * 256 + wave * 32;
    TrSub ta, tb;
    tr_load(ta, W, N, k0, nn, lane);
    tr_load(tb, W, N, k0 + 64, nn, lane);
    tr_store(ta, K, WT, k0, nn, scr, lane);
    tr_load(ta, W, N, k0 + 128, nn, lane);
    tr_store(tb, K, WT, k0 + 64, nn, scr, lane);
    tr_load(tb, W, N, k0 + 192, nn, lane);
    tr_store(ta, K, WT, k0 + 128, nn, scr, lane);
    tr_store(tb, K, WT, k0 + 192, nn, scr, lane);
}
constexpr int PI_GEMV = 2 * (NMOD / 256);
constexpr int PI_TWIN = (D_ / 256) * (WIN / 256), PI_TWOUT = (VW / 256) * (D_ / 256), PI_TWF = (D_ / 256) * (D_ / 256), PI_TW1 = (D_ / 256) * (DFF / 256), PI_TW2 = (DFF / 256) * (D_ / 256);
constexpr int PI_TR = PI_TWIN;
constexpr int PI_DFT = 4, PI_T512 = 8;
constexpr int PI_TOTAL = PI_GEMV + PI_TR + PI_DFT + PI_T512;
__device__ __forceinline__ float cos_rev(float r) { return __builtin_amdgcn_cosf(r); }
__device__ __forceinline__ float sin_rev(float r) { return __builtin_amdgcn_sinf(r); }

__device__ __forceinline__ void p0_prologue(Frame& F, const int qword) {
    int tid = F.tid; asm volatile("" : "+v"(tid)); const int lane = tid & 63;
    LAS float* sc = (LAS float*)(F.lds);
    LAS float* red = (LAS float*)(F.lds + 16384);
    LAS float* scr = (LAS float*)(F.lds + 32768 + F.wave * 8704);
    for (int i = tid; i < D_; i += NWAVES * 64) { const float v = F.c[i]; sc[i] = v / (1.f + __expf(-v)); }
    __syncthreads();
    for (;;) {
        if (tid == 0) F.MISC[0] = __hip_atomic_fetch_add(F.ctl + qword, 1u, RLX_AGENT);
        __syncthreads();
        int it = (int)F.MISC[0];
        __syncthreads();
        if (it >= PI_TOTAL) break;
        if (it < PI_GEMV) {
            const int l = it / (NMOD / 256), n0 = (it % (NMOD / 256)) * 256;
            const float* W = F.ada_w + (size_t)l * D_ * NMOD + n0 + 4 * lane;
            f32x4 a = {0.f, 0.f, 0.f, 0.f};
            const int kb = F.wave * 512;
            for (int k = 0; k < 512; k += 8) {
                f32x4 w[8];
#pragma unroll
                for (int j = 0; j < 8; ++j) w[j] = __builtin_nontemporal_load((const f32x4*)(W + (size_t)(kb + k + j) * NMOD));
#pragma unroll
                for (int j = 0; j < 8; ++j) a += w[j] * sc[kb + k + j];
            }
            *(LAS f32x4*)(red + F.wave * 256 + 4 * lane) = a;
            __syncthreads();
            if (tid < 256) { float s = 0.f;
#pragma unroll
                for (int w = 0; w < 8; ++w) s += red[w * 256 + tid];
                ((float*)(F.ws + WS_MOD))[(size_t)l * NMOD + n0 + tid] = s + F.ada_b[(size_t)l * NMOD + n0 + tid]; }
            __syncthreads();
            continue;
        }
        it -= PI_GEMV;
        if (it < PI_TR) {
            const float* W; bf16* WT; int K, N;
            W = F.w_in; WT = (bf16*)(F.ws + WS_WIN); K = D_; N = WIN;
            tr_item(W, WT, K, N, it, scr, F.wave, lane);
            continue;
        }
        it -= PI_TR;
        if (it < PI_DFT) {
            bf16* Am = (bf16*)(F.ws + WS_AB);
            for (int i = tid; i < 64 * 512; i += NWAVES * 64) {
                const int r = 64 * it + (i >> 9), k = i & 511;
                const float rev = (float)(((k & 255) * r) & 255) * (1.f / 256.f);
                Am[(size_t)r * 512 + k] = pg8::f2bf1((k >> 8) ? sin_rev(rev) : cos_rev(rev));
            }
            continue;
        }
        it -= PI_DFT;
        {
            bf16* T = (bf16*)(F.ws + WS_T512);
            for (int i = tid; i < 128 * 512; i += NWAVES * 64) {
                const int r = 128 * it + (i >> 9), j = i & 511, cs = r >> 9, jp = r & 511;
                const float rev = (float)((j * jp) & 511) * (1.f / 512.f);
                T[(size_t)r * 512 + j] = pg8::f2bf1(cs ? sin_rev(rev) : cos_rev(rev));
            }
        }
    }
}

__device__ __forceinline__ void conv_phase(Frame& F, const float* W, bf16* WT, int K, int N, int nitems, int qword) {
    int tid = F.tid; asm volatile("" : "+v"(tid)); const int lane = tid & 63;
    LAS float* scr = (LAS float*)(F.lds + 32768 + F.wave * 8704);
    for (;;) {
        if (tid == 0) F.MISC[0] = __hip_atomic_fetch_add(F.ctl + qword, 1u, RLX_AGENT);
        __syncthreads();
        const int it = (int)F.MISC[0];
        __syncthreads();
        if (it >= nitems) break;
        tr_item(W, WT, K, N, it, scr, F.wave, lane);
    }
    __syncthreads();
}

template <int MODE, bool XBF>
__device__ __forceinline__ void norm_phase(Frame& F, const void* xin_, const bf16* y, void* xo_, bf16* xn, const float* gate, const float* gy, const float* gn, const float* sc, const float* sh) {
    const int gw = F.bid * NWAVES + F.wave, NGW = F.G * NWAVES;
    int tid = F.tid; asm volatile("" : "+v"(tid)); const int lane = tid & 63;
    LAS float* L = (LAS float*)F.lds;
    for (int i = tid; i < D_; i += NWAVES * 64) {
        if (MODE >= 1) { L[i] = gate[i]; L[D_ + i] = gy[i]; }
        if (MODE <= 1) { L[2 * D_ + i] = gn[i]; L[3 * D_ + i] = sc[i] + 1.0f; L[4 * D_ + i] = sh[i]; }
    }
    __syncthreads();
    const LAS float* Ll = L + 8 * lane;
#define NP_UNPK(pk_, o_) do { (o_)[0] = bf_lo((pk_).x); (o_)[1] = bf_hi((pk_).x); (o_)[2] = bf_lo((pk_).y); (o_)[3] = bf_hi((pk_).y); (o_)[4] = bf_lo((pk_).z); (o_)[5] = bf_hi((pk_).z); (o_)[6] = bf_lo((pk_).w); (o_)[7] = bf_hi((pk_).w); } while (0)
#pragma unroll 1
    for (int row = gw; row < S_; row += NGW) {
        const size_t ro = (size_t)row * D_ + 8 * lane;
        float xv[8][8];
        if (XBF) {
            v4u xp[8];
#pragma unroll
            for (int k = 0; k < 8; ++k) xp[k] = *(const GAS v4u*)((const bf16*)xin_ + ro + 512 * k);
#pragma unroll
            for (int k = 0; k < 8; ++k) NP_UNPK(xp[k], xv[k]);
        } else {
#pragma unroll
            for (int k = 0; k < 8; ++k) { const f32x4 a = *(const GAS f32x4*)((const float*)xin_ + ro + 512 * k), b = *(const GAS f32x4*)((const float*)xin_ + ro + 512 * k + 4);
                xv[k][0] = a.x; xv[k][1] = a.y; xv[k][2] = a.z; xv[k][3] = a.w; xv[k][4] = b.x; xv[k][5] = b.y; xv[k][6] = b.z; xv[k][7] = b.w; }
        }
        if (MODE >= 1) {
            v4u yp[8]; float ss = 0.f;
#pragma unroll
            for (int k = 0; k < 8; ++k) yp[k] = *(const GAS v4u*)(y + ro + 512 * k);
#pragma unroll
            for (int k = 0; k < 8; ++k) { float t[8]; NP_UNPK(yp[k], t); ss += ((t[0] * t[0] + t[1] * t[1]) + (t[2] * t[2] + t[3] * t[3])) + ((t[4] * t[4] + t[5] * t[5]) + (t[6] * t[6] + t[7] * t[7])); }
            const float rs = 1.0f / sqrtf(wave_sum(ss) * (1.f / D_) + EPS_);
#pragma unroll
            for (int k = 0; k < 8; ++k) asm volatile("" : "+v"(yp[k].x), "+v"(yp[k].y), "+v"(yp[k].z), "+v"(yp[k].w));
#pragma unroll
            for (int k = 0; k < 8; ++k) {
                const f32x4 g0 = *(const LAS f32x4*)(Ll + 512 * k), g1 = *(const LAS f32x4*)(Ll + 512 * k + 4), w0 = *(const LAS f32x4*)(Ll + D_ + 512 * k), w1 = *(const LAS f32x4*)(Ll + D_ + 512 * k + 4);
                const float gg[8] = {g0.x, g0.y, g0.z, g0.w, g1.x, g1.y, g1.z, g1.w}, ww[8] = {w0.x, w0.y, w0.z, w0.w, w1.x, w1.y, w1.z, w1.w};
                float t[8]; NP_UNPK(yp[k], t);
#pragma unroll
                for (int e = 0; e < 8; ++e) xv[k][e] = xv[k][e] + gg[e] * ((t[e] * rs) * ww[e]);
                if (MODE == 2) { *(GAS f32x4*)((float*)xo_ + ro + 512 * k) = (f32x4){xv[k][0], xv[k][1], xv[k][2], xv[k][3]}; *(GAS f32x4*)((float*)xo_ + ro + 512 * k + 4) = (f32x4){xv[k][4], xv[k][5], xv[k][6], xv[k][7]}; }
                else { v4u o; o.x = pk2(xv[k][0], xv[k][1]); o.y = pk2(xv[k][2], xv[k][3]); o.z = pk2(xv[k][4], xv[k][5]); o.w = pk2(xv[k][6], xv[k][7]); *(GAS v4u*)((bf16*)xo_ + ro + 512 * k) = o; }
                if ((k & 1) == 1) __builtin_amdgcn_sched_barrier(0); }
        }
        if (MODE <= 1) {
            float ss = 0.f;
#pragma unroll
            for (int k = 0; k < 8; ++k) ss += ((xv[k][0] * xv[k][0] + xv[k][1] * xv[k][1]) + (xv[k][2] * xv[k][2] + xv[k][3] * xv[k][3])) + ((xv[k][4] * xv[k][4] + xv[k][5] * xv[k][5]) + (xv[k][6] * xv[k][6] + xv[k][7] * xv[k][7]));
            const float rs = 1.0f / sqrtf(wave_sum(ss) * (1.f / D_) + EPS_);
#pragma unroll
            for (int k = 0; k < 8; ++k) {
                float h[8];
#pragma unroll
                for (int q = 0; q < 2; ++q) { const f32x4 w = *(const LAS f32x4*)(Ll + 2 * D_ + 512 * k + 4 * q), a = *(const LAS f32x4*)(Ll + 3 * D_ + 512 * k + 4 * q), b = *(const LAS f32x4*)(Ll + 4 * D_ + 512 * k + 4 * q);
                    h[4 * q] = ((xv[k][4 * q] * rs) * w.x) * a.x + b.x; h[4 * q + 1] = ((xv[k][4 * q + 1] * rs) * w.y) * a.y + b.y; h[4 * q + 2] = ((xv[k][4 * q + 2] * rs) * w.z) * a.z + b.z; h[4 * q + 3] = ((xv[k][4 * q + 3] * rs) * w.w) * a.w + b.w; }
                v4u o; o.x = pk2(h[0], h[1]); o.y = pk2(h[2], h[3]); o.z = pk2(h[4], h[5]); o.w = pk2(h[6], h[7]); *(GAS v4u*)(xn + ro + 512 * k) = o;
                if ((k & 1) == 1) __builtin_amdgcn_sched_barrier(0); }
        }
    }
#undef NP_UNPK
    __syncthreads();
}

template <int NB> __device__ __forceinline__ void dma_blocks(const void* gsrc, LAS unsigned char* ldst, int tid, int wave) {
#pragma unroll
    for (int i = 0; i < NB; ++i) __builtin_amdgcn_global_load_lds((const unsigned*)((const char*)gsrc + i * 8192 + tid * 16), (LAS unsigned*)(ldst + i * 8192 + wave * 1024), 16, 0, 0);
}
#define STAGE_SYNC() do { asm volatile("s_waitcnt vmcnt(0) lgkmcnt(0)" ::: "memory"); __builtin_amdgcn_s_barrier(); asm volatile("" ::: "memory"); } while (0)

__device__ __forceinline__ void rs_phase(Frame& F) {
    const bf16* KFT = (const bf16*)(F.ws + WS_KFT); const bf16* KBT = (const bf16*)(F.ws + WS_KBT); const bf16* VT = (const bf16*)(F.ws + WS_VT); bf16* ST = (bf16*)(F.ws + WS_ST);
    int tid = F.tid; asm volatile("" : "+v"(tid)); const int lane = tid & 63;
    const int r = lane & 31, hh = lane >> 5, w = F.wave, wa = w >> 1, wb = w & 1;
    LAS unsigned char* L = F.lds;
    constexpr int SB = 32768;
    const unsigned aoff = (unsigned)(hh * 2048 + (32 * wa + r) * 16);
    const unsigned boff = (unsigned)(16384 + hh * 2048 + (64 * wb + r) * 16);
    const int vb = (F.G % 8 == 0) ? (F.bid % 8) * (F.G / 8) + F.bid / 8 : F.bid;
    for (int job = vb; job < H_ * 2 * 2 * 4; job += F.G) {
        const int h = job >> 4, d = (job >> 3) & 1, dh = (job >> 2) & 1, e = job & 3;
        const float l2 = pg8::lg2_sigmoid(d ? F.decb[h] : F.decf[h]);
        const float cdec = __builtin_amdgcn_exp2f((float)pg8::RC * l2);
        f32x16 acc[2];
#pragma unroll
        for (int t = 0; t < 2; ++t)
#pragma unroll
            for (int i = 0; i < 16; ++i) acc[t][i] = 0.f;
        const bf16* KT = d ? KBT : KFT;
        const int pidx = ((w >> 2) * 2 + ((w >> 1) & 1)) * 2 + (w & 1);
        const size_t kpiece = ((size_t)pidx * 256 + 128 * dh + lane) * 8, vpiece = ((size_t)pidx * 512 + 128 * e + lane) * 8;
#define RS_ISSUE(step_, sub_, buf_) do { const int c_ = d ? (NCH - 1 - (step_)) : (step_); const size_t tb_ = (size_t)(h * 256 + c_ * 8 + 2 * (sub_)); \
        LAS unsigned char* lb_ = L + (buf_) * SB + w * 2048; \
        __builtin_amdgcn_global_load_lds((const unsigned*)(KT + tb_ * 8192 + kpiece), (LAS unsigned*)(lb_), 16, 0, 0); \
        __builtin_amdgcn_global_load_lds((const unsigned*)(KT + tb_ * 8192 + kpiece + 512), (LAS unsigned*)(lb_ + 1024), 16, 0, 0); \
        __builtin_amdgcn_global_load_lds((const unsigned*)(VT + tb_ * 16384 + vpiece), (LAS unsigned*)(lb_ + 16384), 16, 0, 0); \
        __builtin_amdgcn_global_load_lds((const unsigned*)(VT + tb_ * 16384 + vpiece + 512), (LAS unsigned*)(lb_ + 16384 + 1024), 16, 0, 0); } while (0)
        RS_ISSUE(0, 0, 0); RS_ISSUE(0, 1, 1);
        int bcur = 0;
#pragma unroll 1
        for (int step = 0; step < NCH; ++step) {
            const int c = d ? (NCH - 1 - step) : step;
#pragma unroll
            for (int sub = 0; sub < 4; ++sub) {
                if (step == NCH - 1 && sub == 3) asm volatile("s_waitcnt vmcnt(0) lgkmcnt(0)" ::: "memory"); else asm volatile("s_waitcnt vmcnt(4) lgkmcnt(0)" ::: "memory");
                __builtin_amdgcn_s_barrier(); asm volatile("" ::: "memory");
                { const int bn = bcur >= 1 ? bcur - 1 : 2;
                  if (sub < 2) RS_ISSUE(step, sub + 2, bn); else if (step + 1 < NCH) RS_ISSUE(step + 1, sub - 2, bn); }
                if (sub == 0) {
                    bf16* so = ST + ((((size_t)((h * NCH + c) * 2 + d) * 8 + 4 * dh + wa) * 4) * 512 + 128 * e + 64 * wb + r) * 8 + 4 * hh;
#pragma unroll
                    for (int t = 0; t < 2; ++t)
#pragma unroll
                        for (int g4 = 0; g4 < 4; ++g4) { v2u o; o.x = pk2(acc[t][4 * g4], acc[t][4 * g4 + 1]); o.y = pk2(acc[t][4 * g4 + 2], acc[t][4 * g4 + 3]);
                            *(GAS v2u*)(so + ((size_t)g4 * 512 + 32 * t) * 8) = o; }
#pragma unroll
                    for (int t = 0; t < 2; ++t)
#pragma unroll
                        for (int i = 0; i < 16; ++i) acc[t][i] *= cdec;
                }
                const LAS unsigned char* B = L + bcur * SB;
#pragma unroll
                for (int kbi = 0; kbi < 2; ++kbi)
#pragma unroll
                    for (int s2 = 0; s2 < 2; ++s2) {
                        const bf16x8 a = *(const LAS bf16x8*)(B + aoff + (kbi * 2 + s2) * 4096);
                        const bf16x8 b0 = *(const LAS bf16x8*)(B + boff + (kbi * 2 + s2) * 4096), b1 = *(const LAS bf16x8*)(B + boff + (kbi * 2 + s2) * 4096 + 512);
                        acc[0] = __builtin_amdgcn_mfma_f32_32x32x16_bf16(a, b0, acc[0], 0, 0, 0);
                        acc[1] = __builtin_amdgcn_mfma_f32_32x32x16_bf16(a, b1, acc[1], 0, 0, 0);
                    }
                bcur = bcur == 2 ? 0 : bcur + 1;
            }
        }
#undef RS_ISSUE
        asm volatile("s_waitcnt lgkmcnt(0)" ::: "memory"); __builtin_amdgcn_s_barrier(); asm volatile("" ::: "memory");
    }
}

__device__ __forceinline__ void r3_phase(Frame& F) {
    const bf16* Q0 = (const bf16*)(F.ws + WS_Q0); const bf16* K0 = (const bf16*)(F.ws + WS_K0);
    const bf16* VT = (const bf16*)(F.ws + WS_VT); const bf16* ST = (const bf16*)(F.ws + WS_ST); const bf16* SG = (const bf16*)(F.ws + WS_SG); bf16* A2 = (bf16*)(F.ws + WS_A2);
    LAS unsigned char* L = F.lds;
    constexpr int QL = 98304, NQL = 12, NGR = 56, NSLOT = 6, AHEAD = 5;
    LAS float* red = (LAS float*)(F.lds + 147456);
    LAS float* gnl = (LAS float*)(F.lds + 149504);
    int tid = F.tid; asm volatile("" : "+v"(tid)); const int lane = tid & 63;
    const int r = lane & 31, hh = lane >> 5, w = F.wave, wr = w >> 1, wc = w & 1;
    const unsigned koff = (unsigned)(hh * 512 + r * 16);
    const unsigned voff = (unsigned)(hh * 8192 + wc * 4096 + r * 16);
    const unsigned qoff = (unsigned)(QL + wr * (NQL * 1024) + hh * 512 + r * 16);
    const int NU = H_ * (S_ / 128);
#define R3_GRAN(uu_, n_, sl_) do { const int hq_ = (uu_) >> 6, cq_ = ((uu_) & 63) >> 1; const bf16* src_; \
        if ((n_) < 32) { const int d_ = 1 - ((n_) >> 4), s8_ = ((n_) >> 1) & 7; src_ = ST + ((size_t)((hq_ * NCH + cq_) * 2 + d_) * 8 + s8_) * 16384 + ((n_) & 1) * 8192; } \
        else { const int m_ = (n_) - 32, kb_ = m_ / 3, pt_ = m_ - 3 * kb_; const size_t tb_ = (size_t)(hq_ * 256 + cq_ * 8 + kb_); src_ = pt_ == 0 ? K0 + tb_ * 8192 : VT + tb_ * 16384 + (pt_ - 1) * 8192; } \
        dma_blocks<2>(src_, L + (sl_) * 16384, tid, w); } while (0)
#define R3_ISSUE_Q(uu_) do { _Pragma("unroll") for (int p_ = 0; p_ < 6; ++p_) { const int pc_ = 6 * w + p_, g_ = pc_ / NQL, i_ = pc_ % NQL; \
        __builtin_amdgcn_global_load_lds((const unsigned*)(Q0 + ((size_t)(((uu_) >> 6) * 256 + ((uu_) & 63) * 4 + g_) * 16 + i_) * 512 + lane * 8), (LAS unsigned*)(L + QL + g_ * (NQL * 1024) + i_ * 1024), 16, 0, 0); } } while (0)
#define R3_STEP(n_, drain_) do { if (drain_) asm volatile("s_waitcnt vmcnt(0) lgkmcnt(0)" ::: "memory"); else asm volatile("s_waitcnt vmcnt(8) lgkmcnt(0)" ::: "memory"); \
        __builtin_amdgcn_s_barrier(); asm volatile("" ::: "memory"); \
        { const int gi_ = (n_) + AHEAD; const int fs_ = slot == 0 ? NSLOT - 1 : slot - 1; \
          if (gi_ < NGR) R3_GRAN(u, gi_, fs_); else if (has_next) R3_GRAN(u + F.G, gi_ - NGR, fs_); } } while (0)
    int u = (F.G % 8 == 0) ? (F.bid % 8) * (F.G / 8) + F.bid / 8 : F.bid;
    int slot = 0;
    if (u < NU) {
#pragma unroll
        for (int g = 0; g < AHEAD; ++g) R3_GRAN(u, g, g);
        R3_ISSUE_Q(u);
    }
#pragma unroll 1
    for (; u < NU; u += F.G) {
        const int h = u >> 6, qb = u & 63;
        const int tq = qb * 128 + 32 * wr + r, jq = tq & (pg8::RC - 1);
        const bool has_next = (u + F.G) < NU;
        const float lf2 = pg8::lg2_sigmoid(F.decf[h]), lb2 = pg8::lg2_sigmoid(F.decb[h]);
        const size_t qfo = ((size_t)(h * 256 + qb * 4 + wr) * 1024 + hh * 32 + r) * 8;
        bf16x8 qr[16 - NQL];
#pragma unroll
        for (int i = 0; i < 16 - NQL; ++i) qr[i] = *(const GAS bf16x8*)(Q0 + qfo + (NQL + i) * 512);
        f32x16 acc[8];
#pragma unroll
        for (int t = 0; t < 8; ++t)
#pragma unroll
            for (int i = 0; i < 16; ++i) acc[t][i] = 0.f;
        const float qfs = __builtin_amdgcn_exp2f((float)(jq + 1) * lf2), qbs = __builtin_amdgcn_exp2f((float)(pg8::RC - jq) * lb2);
#pragma unroll 1
        for (int dd = 0; dd < 2; ++dd) {
#pragma unroll
            for (int sl = 0; sl < 8; ++sl)
#pragma unroll
                for (int k2 = 0; k2 < 2; ++k2) {
                    const int n = dd * 16 + sl * 2 + k2;
                    R3_STEP(n, n == 0);
                    const LAS unsigned char* B = L + slot * 16384;
                    const int ks = 2 * sl + k2;
                    bf16x8 qv; if (ks < NQL) qv = *(const LAS bf16x8*)(L + qoff + ks * 1024); else qv = qr[ks < NQL ? 0 : ks - NQL];
#pragma unroll
                    for (int t = 0; t < 8; ++t) { const bf16x8 a = *(const LAS bf16x8*)(B + voff + t * 512);
                        acc[t] = __builtin_amdgcn_mfma_f32_32x32x16_bf16(a, qv, acc[t], 0, 0, 0); if ((t & 3) == 3) __builtin_amdgcn_sched_barrier(0); }
                    slot = slot == NSLOT - 1 ? 0 : slot + 1;
                }
            const float scl = dd == 0 ? qbs / qfs : qfs;
#pragma unroll
            for (int t = 0; t < 8; ++t)
#pragma unroll
                for (int i = 0; i < 16; ++i) acc[t][i] *= scl;
        }
#pragma unroll 1
        for (int kb = 0; kb < 8; ++kb) {
            const int n0 = 32 + 3 * kb;
            const bool tail = !has_next && n0 + 2 + (AHEAD - 1) >= NGR;
            R3_STEP(n0, tail);
            bf16x8 pf[2];
            {
                const LAS unsigned char* B = L + slot * 16384;
                f32x16 sc;
#pragma unroll
                for (int i = 0; i < 16; ++i) sc[i] = 0.f;
#pragma unroll
                for (int ks = 0; ks < NQL; ++ks) { const bf16x8 a = *(const LAS bf16x8*)(B + koff + ks * 1024), b = *(const LAS bf16x8*)(L + qoff + ks * 1024);
                    sc = __builtin_amdgcn_mfma_f32_32x32x16_bf16(a, b, sc, 0, 0, 0); if ((ks & 1) == 1) __builtin_amdgcn_sched_barrier(0); }
#pragma unroll
                for (int ks = NQL; ks < 16; ++ks) { const bf16x8 a = *(const LAS bf16x8*)(B + koff + ks * 1024); sc = __builtin_amdgcn_mfma_f32_32x32x16_bf16(a, qr[ks - NQL], sc, 0, 0, 0); }
#pragma unroll
                for (int i = 0; i < 16; ++i) { const int jm = 32 * kb + (i & 3) + 8 * (i >> 2) + 4 * hh; const int df = jq - jm;
                    const float dm = df > 0 ? __builtin_amdgcn_exp2f((float)df * lf2) : (df < 0 ? __builtin_amdgcn_exp2f((float)(-df) * lb2) : 2.0f); sc[i] *= dm; }
#pragma unroll
                for (int s2 = 0; s2 < 2; ++s2) { v4u p; p.x = pk2(sc[8 * s2], sc[8 * s2 + 1]); p.y = pk2(sc[8 * s2 + 2], sc[8 * s2 + 3]); p.z = pk2(sc[8 * s2 + 4], sc[8 * s2 + 5]); p.w = pk2(sc[8 * s2 + 6], sc[8 * s2 + 7]); pf[s2] = __builtin_bit_cast(bf16x8, p); }
                slot = slot == NSLOT - 1 ? 0 : slot + 1;
            }
#pragma unroll
            for (int s2 = 0; s2 < 2; ++s2) {
                R3_STEP(n0 + 1 + s2, tail);
                const LAS unsigned char* B = L + slot * 16384;
#pragma unroll
                for (int t = 0; t < 8; ++t) { const bf16x8 av = *(const LAS bf16x8*)(B + voff + t * 512);
                    acc[t] = __builtin_amdgcn_mfma_f32_32x32x16_bf16(av, pf[s2], acc[t], 0, 0, 0); if ((t & 3) == 3) __builtin_amdgcn_sched_barrier(0); }
                slot = slot == NSLOT - 1 ? 0 : slot + 1;
            }
        }
        const int cb = h * DV + 256 * wc + 4 * hh;
        const bf16* sg = SG + (size_t)tq * VW + cb; bf16* ao = A2 + (size_t)tq * VW + cb;
        v2u gwv[32];
#pragma unroll
        for (int t = 0; t < 8; ++t)
#pragma unroll
            for (int g4 = 0; g4 < 4; ++g4) gwv[4 * t + g4] = *(const GAS v2u*)(sg + 32 * t + 8 * g4);
        gnl[tid] = F.gn_g[h * DV + tid];
        float s1 = 0.f;
#pragma unroll
        for (int t = 0; t < 8; ++t)
#pragma unroll
            for (int i = 0; i < 16; ++i) s1 += acc[t][i];
        s1 += __shfl_xor(s1, 32);
        if (hh == 0) red[(wr * 2 + wc) * 32 + r] = s1;
        __syncthreads();
        if (has_next) R3_ISSUE_Q(u + F.G);
        const float mean = (red[(wr * 2) * 32 + r] + red[(wr * 2 + 1) * 32 + r]) * (1.f / DV);
        float s2 = 0.f;
#pragma unroll
        for (int t = 0; t < 8; ++t)
#pragma unroll
            for (int i = 0; i < 16; ++i) { const float dlt = acc[t][i] - mean; s2 += dlt * dlt; }
        s2 += __shfl_xor(s2, 32);
        if (hh == 0) red[256 + (wr * 2 + wc) * 32 + r] = s2;
        __syncthreads();
        const float rstd = 1.0f / sqrtf((red[256 + (wr * 2) * 32 + r] + red[256 + (wr * 2 + 1) * 32 + r]) * (1.f / DV) + EPS_);
        const LAS float* gg = gnl + 256 * wc + 4 * hh;
#pragma unroll
        for (int t = 0; t < 8; ++t) {
#pragma unroll
            for (int g4 = 0; g4 < 4; ++g4) {
                const int o = 32 * t + 8 * g4;
                const v2u gw = gwv[4 * t + g4]; const f32x4 gv = *(const LAS f32x4*)(gg + o);
                const float y0 = (acc[t][4 * g4] - mean) * rstd * gv.x * bf_lo(gw.x), y1 = (acc[t][4 * g4 + 1] - mean) * rstd * gv.y * bf_hi(gw.x);
                const float y2 = (acc[t][4 * g4 + 2] - mean) * rstd * gv.z * bf_lo(gw.y), y3 = (acc[t][4 * g4 + 3] - mean) * rstd * gv.w * bf_hi(gw.y);
                v2u ov; ov.x = pk2(y0, y1); ov.y = pk2(y2, y3); *(GAS v2u*)(ao + o) = ov;
            }
            if (t & 1) __builtin_amdgcn_sched_barrier(0); }
    }
#undef R3_GRAN
#undef R3_STEP
#undef R3_ISSUE_Q
    asm volatile("s_waitcnt vmcnt(0) lgkmcnt(0)" ::: "memory"); __syncthreads();
}

__device__ constexpr float W32C[16] = {1.000000000f, 0.980785280f, 0.923879533f, 0.831469612f, 0.707106781f, 0.555570233f, 0.382683432f, 0.195090322f, 0.000000000f, -0.195090322f, -0.382683432f, -0.555570233f, -0.707106781f, -0.831469612f, -0.923879533f, -0.980785280f};
__device__ constexpr float W32S[16] = {0.000000000f, 0.195090322f, 0.382683432f, 0.555570233f, 0.707106781f, 0.831469612f, 0.923879533f, 0.980785280f, 1.000000000f, 0.980785280f, 0.923879533f, 0.831469612f, 0.707106781f, 0.555570233f, 0.382683432f, 0.195090322f};
__host__ __device__ constexpr int brev5(int p) { return ((p & 1) << 4) | ((p & 2) << 2) | (p & 4) | ((p & 8) >> 2) | ((p & 16) >> 4); }
__device__ __forceinline__ void ffta_phase(Frame& F) {
    const bf16* Yt = (const bf16*)(F.ws + WS_YT); bf16* Gm = (bf16*)(F.ws + WS_G);
    int tid = F.tid; asm volatile("" : "+v"(tid));
#pragma unroll 1
    for (int idx = F.bid * (NWAVES * 64) + tid; idx < D_ * 256; idx += F.G * (NWAVES * 64)) {
        const int col = idx >> 8, s2 = idx & 255;
        const GAS bf16* src = (const GAS bf16*)(Yt + (size_t)col * 16384 + s2);
        float xr[32], xi[32];
#pragma unroll
        for (int s1 = 0; s1 < 32; ++s1) { xr[s1] = __builtin_bit_cast(float, (unsigned)src[256 * s1] << 16); xi[s1] = -__builtin_bit_cast(float, (unsigned)src[8192 + 256 * s1] << 16); }
#pragma unroll
        for (int len = 32; len >= 2; len >>= 1) {
            const int half = len >> 1, step = 32 / len;
#pragma unroll
            for (int i = 0; i < 32; i += len)
#pragma unroll
                for (int j = 0; j < half; ++j) {
                    const float ar = xr[i + j], ai = xi[i + j], br = xr[i + j + half], bi = xi[i + j + half];
                    xr[i + j] = ar + br; xi[i + j] = ai + bi;
                    const float dr = ar - br, di = ai - bi, c = W32C[j * step], sn = W32S[j * step];
                    xr[i + j + half] = dr * c + di * sn; xi[i + j + half] = di * c - dr * sn;
                }
        }
        GAS bf16* dst = (GAS bf16*)(Gm + (size_t)col * 512 + s2);
#pragma unroll
        for (int p = 0; p < 32; ++p) {
            const int k = brev5(p);
            const float rev = (float)((s2 * k) & 8191) * (1.f / 8192.f); const float c = cos_rev(rev), sn = sin_rev(rev);
            const float gr = xr[p] * c + xi[p] * sn, gi = xi[p] * c - xr[p] * sn;
            dst[(size_t)k * (D_ * 512)] = pg8::f2bf1(gr); dst[(size_t)k * (D_ * 512) + 256] = pg8::f2bf1(gi);
        }
    }
}

constexpr int NPH = 18;
__global__ void __launch_bounds__(NWAVES * 64, 2) enc_fwd(Args args) {
    extern __shared__ __attribute__((aligned(16))) unsigned char lds[];
    Frame F;
    F.lds = (LAS unsigned char*)lds; F.MISC = (volatile LAS unsigned*)(F.lds + MISC_OFF);
    F.tid = threadIdx.x; F.wave = __builtin_amdgcn_readfirstlane(F.tid >> 6); F.G = gridDim.x; F.bid = blockIdx.x;
    F.ws = args.ws; F.ctl = (unsigned*)(args.ws + WS_CTL);
    F.x = args.in[0]; F.c = args.in[1]; F.ada_w = args.in[2]; F.ada_b = args.in[3]; F.norm_g = args.in[4]; F.w_in = args.in[5]; F.w_out = args.in[6]; F.gn_g = args.in[7];
    F.decf = args.in[8]; F.decb = args.in[9]; F.fno_w = args.in[10]; F.fno_b = args.in[11]; F.w1 = args.in[12]; F.w2 = args.in[13]; F.out = args.out;
    for (int u = F.tid; u < (LDS_BYTES - LDSCTL_OFF) / 4; u += NWAVES * 64) ((LAS unsigned*)(F.lds + LDSCTL_OFF))[u] = 0u;
    __syncthreads();
    const int lo = args.ph_lo, hi = args.ph_hi;
    XcdBarrier bar; bar.bar = (unsigned*)(F.ctl + CW_BAR) + args.li * XCD_BAR_WORDS; bar.x = 0; bar.st = nullptr;
    if (hi - lo > 1) bar = xcd_barrier_post((unsigned*)(F.ctl + CW_BAR) + args.li * XCD_BAR_WORDS, F.MISC + 8);
#ifndef PHMASK
#define PHMASK 0x3ffff
#endif
#define IN(k) (((PHMASK >> (k)) & 1) && lo <= (k) && (k) < hi)
#define SEAM(k) do { if (IN(k) && IN((k) + 1)) xcd_barrier(bar); } while (0)
    unsigned char* ws = args.ws;
    const float* MOD = (const float*)(ws + WS_MOD);
    bf16* XN = (bf16*)(ws + WS_XN); bf16* XA = (bf16*)(ws + WS_XA); bf16* Y = (bf16*)(ws + WS_Y); bf16* HB = (bf16*)(ws + WS_HB);
    const float* NG = F.norm_g;
#define MODV(l, i) (MOD + (size_t)(l) * NMOD + (i) * D_)
#define NGV(l, i) (NG + ((l) * 4 + (i)) * D_)

    if (IN(0)) { p0_prologue(F, CW_Q); } SEAM(0);
    if (IN(1)) { norm_phase<0, false>(F, F.x, nullptr, nullptr, XN, nullptr, nullptr, NGV(0, 0), MODV(0, 1), MODV(0, 0)); } SEAM(1);
    if (IN(2)) {
        pg8::Gemm g{XN, (const bf16*)(ws + WS_WIN), D_, D_, D_, 0, 0}; pg8::StaticOrder S; S.init(S_, WIN, F.G, F.bid);
        pg8::EpiWin E{(bf16*)(ws + WS_Q0), (bf16*)(ws + WS_K0), (bf16*)(ws + WS_KFT), (bf16*)(ws + WS_KBT), (bf16*)(ws + WS_VT), (bf16*)(ws + WS_SG),
                      F.decf, F.decb, S_, F.lds + 131072};
        pg8::gemm_phase<pg8::EpiWin, pg8::StaticOrder, PG8_ALIGN, PG8_SP2>(F.lds + RING_OFF, g, S, E);
    } SEAM(2);
    if (IN(3)) { rs_phase(F); } SEAM(3);
    if (IN(4)) { r3_phase(F); conv_phase(F, F.w_out, (bf16*)(ws + WS_WOUT), VW, D_, PI_TWOUT, CW_Q + 64); } SEAM(4);
    if (IN(5)) {
        pg8::Gemm g{(const bf16*)(ws + WS_A2), (const bf16*)(ws + WS_WOUT), VW, VW, VW, 0, 0}; pg8::StaticOrder S; S.init(S_, D_, F.G, F.bid);
        pg8::EpiBf16<0> E{Y, D_, nullptr};
        pg8::gemm_phase<pg8::EpiBf16<0>, pg8::StaticOrder, PG8_ALIGN, PG8_SP2>(F.lds + RING_OFF, g, S, E);
    } SEAM(5);
    if (IN(6)) { norm_phase<1, false>(F, F.x, Y, XA, XN, MODV(0, 2), NGV(0, 1), NGV(0, 2), MODV(0, 4), MODV(0, 3)); conv_phase(F, F.w1, (bf16*)(ws + WS_W1), D_, DFF, PI_TW1, CW_Q + 128); } SEAM(6);
    if (IN(7)) {
        pg8::Gemm g{XN, (const bf16*)(ws + WS_W1), D_, D_, D_, 0, 0}; pg8::StaticOrder S; S.init(S_, DFF, F.G, F.bid);
        pg8::EpiBf16<1> E{HB, DFF, nullptr};
        pg8::gemm_phase<pg8::EpiBf16<1>, pg8::StaticOrder, PG8_ALIGN, PG8_SP2>(F.lds + RING_OFF, g, S, E);
        conv_phase(F, F.w2, (bf16*)(ws + WS_W2), DFF, D_, PI_TW2, CW_Q + 256);
    } SEAM(7);
    if (IN(8)) {
        pg8::Gemm g{HB, (const bf16*)(ws + WS_W2), DFF, DFF, DFF, 0, 0}; pg8::StaticOrder S; S.init(S_, D_, F.G, F.bid);
        pg8::EpiBf16<0> E{Y, D_, nullptr};
        pg8::gemm_phase<pg8::EpiBf16<0>, pg8::StaticOrder, PG8_ALIGN, PG8_SP2>(F.lds + RING_OFF, g, S, E);
    } SEAM(8);
    if (IN(9)) { norm_phase<1, true>(F, XA, Y, XA, XN, MODV(0, 5), NGV(0, 3), NGV(1, 0), MODV(1, 1), MODV(1, 0)); } SEAM(9);
    if (IN(10)) {
        pg8::Gemm g{(const bf16*)(ws + WS_T512), XN, 512, D_, 512, 0, 512}; pg8::BatchOrder S; S.init(1024, S_, 8, F.G, F.bid);
        pg8::EpiFft1 E{(bf16*)(ws + WS_YT)};
        pg8::gemm_phase<pg8::EpiFft1, pg8::BatchOrder, PG8_ALIGN, PG8_SP2>(F.lds + RING_OFF, g, S, E);
    } SEAM(10);
    if (IN(11)) { ffta_phase(F); } SEAM(11);
    if (IN(12)) {
        pg8::Gemm g{(const bf16*)(ws + WS_AB), (const bf16*)(ws + WS_G), 512, 512, 512, 0, (size_t)D_ * 512}; pg8::BatchOrder S; S.init(256, D_, 32, F.G, F.bid);
        pg8::EpiMixB E{(bf16*)(ws + WS_MIX)};
        pg8::gemm_phase<pg8::EpiMixB, pg8::BatchOrder, PG8_ALIGN, PG8_SP2>(F.lds + RING_OFF, g, S, E);
        conv_phase(F, F.fno_w, (bf16*)(ws + WS_WF), D_, D_, PI_TWF, CW_Q + 384);
    } SEAM(12);
    if (IN(13)) {
        pg8::Gemm g{(const bf16*)(ws + WS_MIX), (const bf16*)(ws + WS_WF), D_, D_, D_, 0, 0}; pg8::StaticOrder S; S.init(S_, D_, F.G, F.bid);
        pg8::EpiBf16<0> E{Y, D_, F.fno_b};
        pg8::gemm_phase<pg8::EpiBf16<0>, pg8::StaticOrder, PG8_ALIGN, PG8_SP2>(F.lds + RING_OFF, g, S, E);
    } SEAM(13);
    if (IN(14)) { norm_phase<1, true>(F, XA, Y, XA, XN, MODV(1, 2), NGV(1, 1), NGV(1, 2), MODV(1, 4), MODV(1, 3)); conv_phase(F, F.w1 + (size_t)D_ * DFF, (bf16*)(ws + WS_W1) + (size_t)D_ * DFF, D_, DFF, PI_TW1, CW_Q + 192); } SEAM(14);
    if (IN(15)) {
        pg8::Gemm g{XN, (const bf16*)(ws + WS_W1) + (size_t)D_ * DFF, D_, D_, D_, 0, 0}; pg8::StaticOrder S; S.init(S_, DFF, F.G, F.bid);
        pg8::EpiBf16<1> E{HB, DFF, nullptr};
        pg8::gemm_phase<pg8::EpiBf16<1>, pg8::StaticOrder, PG8_ALIGN, PG8_SP2>(F.lds + RING_OFF, g, S, E);
        conv_phase(F, F.w2 + (size_t)D_ * DFF, (bf16*)(ws + WS_W2) + (size_t)D_ * DFF, DFF, D_, PI_TW2, CW_Q + 320);
    } SEAM(15);
    if (IN(16)) {
        pg8::Gemm g{HB, (const bf16*)(ws + WS_W2) + (size_t)D_ * DFF, DFF, DFF, DFF, 0, 0}; pg8::StaticOrder S; S.init(S_, D_, F.G, F.bid);
        pg8::EpiBf16<0> E{Y, D_, nullptr};
        pg8::gemm_phase<pg8::EpiBf16<0>, pg8::StaticOrder, PG8_ALIGN, PG8_SP2>(F.lds + RING_OFF, g, S, E);
    } SEAM(16);
    if (IN(17)) { norm_phase<2, true>(F, XA, Y, F.out, nullptr, MODV(1, 5), NGV(1, 3), nullptr, nullptr, nullptr); }
#undef IN
#undef SEAM
}

extern "C" void kernel_launch(void* const* d_in, const int* in_sizes, int n_in, void* d_out, int out_size, void* d_ws, size_t ws_size, hipStream_t stream) {
    static int grid = 0;
    if (grid == 0) {
        if (n_in != 14 || out_size != S_ * D_ || ws_size < WS_END) { fprintf(stderr, "kernel_launch: unexpected problem (n_in %d, out %d, ws %zu < %zu)\n", n_in, out_size, ws_size, (size_t)WS_END); grid = -1; return; }
        int dev = 0, cus = 0, per_cu = 0;
        if (hipGetDevice(&dev) != hipSuccess || hipDeviceGetAttribute(&cus, hipDeviceAttributeMultiprocessorCount, dev) != hipSuccess) { grid = -1; return; }
        if (hipFuncSetAttribute((const void*)enc_fwd, hipFuncAttributeMaxDynamicSharedMemorySize, LDS_BYTES) != hipSuccess) { fprintf(stderr, "kernel_launch: hipFuncSetAttribute failed\n"); grid = -1; return; }
        if (hipOccupancyMaxActiveBlocksPerMultiprocessor(&per_cu, (const void*)enc_fwd, NWAVES * 64, LDS_BYTES) != hipSuccess || per_cu < 1) fprintf(stderr, "kernel_launch: occupancy query reports %d\n", per_cu);
        (void)hipGetLastError();
        grid = cus;
    }
    if (grid < 0) return;
    (void)hipMemsetAsync((char*)d_ws + WS_CTL, 0, CTL_ZERO_BYTES, stream);
    Args a{};
    for (int i = 0; i < 14; ++i) a.in[i] = (const float*)d_in[i];
    a.out = (float*)d_out; a.ws = (unsigned char*)d_ws; a.pad = 0;
#if MK_SINGLE
    a.ph_lo = 0; a.ph_hi = NPH; a.li = 0;
    hipLaunchKernelGGL(enc_fwd, dim3(grid), dim3(NWAVES * 64), LDS_BYTES, stream, a);
#else
    for (int p = 0; p < NPH; ++p) { a.ph_lo = p; a.ph_hi = p + 1; a.li = p; hipLaunchKernelGGL(enc_fwd, dim3(grid), dim3(NWAVES * 64), LDS_BYTES, stream, a); }
#endif
}
```

```cpp
#include <hip/hip_runtime.h>
#include <cstdio>
#include <cstdint>

#ifndef MK_SINGLE
#define MK_SINGLE 1
#endif

namespace pg8 {
#define PG8_LAS __attribute__((address_space(3)))
typedef unsigned short bf16_t;
typedef short bf16x8 __attribute__((ext_vector_type(8)));
typedef float f32x4 __attribute__((ext_vector_type(4)));
typedef unsigned u32x4 __attribute__((ext_vector_type(4)));
constexpr int BM = 256, BK = 64, HALF = 128, HTB = HALF * BK * 2  , STAGE_BYTES = 8 * HTB, NXCD = 8, WGM = 8;

__host__ __device__ __forceinline__ int lds_byte(int r, int c) { const int st = (r >> 4) * 2 + (c >> 5), rr = r & 15, cc = c & 31, ob = rr * 64 + cc * 2; return st * 1024 + (ob ^ (((ob >> 9) & 1) << 5)); }
__host__ __device__ __forceinline__ void stage_rc(int b, int& R, int& C) { const int st = b / 1024, sb = b % 1024, swz = sb ^ (((sb >> 9) & 1) << 5); R = (st >> 1) * 16 + swz / 64; C = (st & 1) * 32 + (swz % 64) / 2; }
__host__ __device__ __forceinline__ int perm32(int rho) { const int n = rho >> 4, i = rho & 15; return 8 * (i >> 2) + 4 * n + (i & 3); }

struct Unit { int pm, pn, z; };
struct Gemm { const bf16_t* A; const bf16_t* Bt; int lda, ldb, K; size_t zA, zB; };

struct StaticOrder {
    int nM, nN, nwg, G, c;
    __host__ __device__ void init(int M, int N, int G_, int c_) { nM = M / BM; nN = N / BM; nwg = nM * nN; G = G_; c = c_; }
    __host__ __device__ bool next(int i, Unit& u) const {
        const long L = (long)i * G + c; if (L >= nwg) return false;
        int wgid = (int)L; { const int q = nwg / NXCD, r = nwg % NXCD, xcd = wgid % NXCD, off = wgid / NXCD; wgid = (xcd < r ? xcd * (q + 1) : r * (q + 1) + (xcd - r) * q) + off; }
        const int nig = WGM * nN, gid = wgid / nig, fm = gid * WGM, gsz = (nM - fm) < WGM ? (nM - fm) : WGM;
        u.pm = fm + ((wgid % nig) % gsz); u.pn = (wgid % nig) / gsz; u.z = 0; return true;
    }
    __device__ __forceinline__ void a_ready(const Unit&) const {}
    __device__ __forceinline__ void done(const Unit&) const {}
};
struct BatchOrder {
    int nM, nN, nz, nwg, G, c;
    __host__ __device__ void init(int M, int N, int nz_, int G_, int c_) { nM = M / BM; nN = N / BM; nz = nz_; nwg = nM * nN * nz; G = G_; c = c_; }
    __host__ __device__ bool next(int i, Unit& u) const {
        const long L = (long)i * G + c; if (L >= nwg) return false;
        const int per = nM * nN, l = (int)L; u.z = l / per; const int r = l % per; u.pn = r / nM; u.pm = r % nM; return true;
    }
    __device__ __forceinline__ void a_ready(const Unit&) const {}
    __device__ __forceinline__ void done(const Unit&) const {}
};

__device__ __forceinline__ unsigned cvt_pk_bf16(float lo, float hi) { unsigned r; asm volatile("v_cvt_pk_bf16_f32 %0, %1, %2" : "=v"(r) : "v"(lo), "v"(hi)); return r; }
__device__ __forceinline__ u32x4 pack8(const f32x4 v0, const f32x4 v1) { u32x4 w; w.x = cvt_pk_bf16(v0[0], v0[1]); w.y = cvt_pk_bf16(v0[2], v0[3]); w.z = cvt_pk_bf16(v1[0], v1[1]); w.w = cvt_pk_bf16(v1[2], v1[3]); return w; }
__device__ __forceinline__ bf16_t f2bf1(float f) { return (bf16_t)(cvt_pk_bf16(f, f) & 0xffffu); }

template <int ACT> struct EpiBf16 {
    static constexpr bool PERM = true, AFTER_DRAIN = false;
    bf16_t* O; int ldc; const float* bias;
    __device__ __forceinline__ void operator()(const f32x4 (&acc)[2][2][4][2], const Unit& u, int wr, int wc, int fr, int fq) const {
        const int row0 = u.pm * BM + wr * 64 + fr; const int col0 = u.pn * BM + wc * 32 + 8 * fq;
        f32x4 bv[2][2];
#pragma unroll
        for (int bj = 0; bj < 2; ++bj)
#pragma unroll
            for (int n = 0; n < 2; ++n) bv[bj][n] = bias ? *(const f32x4*)(bias + col0 + bj * HALF + 4 * n) : (f32x4){0.f, 0.f, 0.f, 0.f};
#pragma unroll
        for (int ai = 0; ai < 2; ++ai)
#pragma unroll
            for (int m = 0; m < 4; ++m) { bf16_t* rowp = O + (size_t)(row0 + ai * HALF + m * 16) * ldc + col0;
#pragma unroll
                for (int bj = 0; bj < 2; ++bj) { f32x4 v0 = acc[ai][bj][m][0] + bv[bj][0], v1 = acc[ai][bj][m][1] + bv[bj][1];
                    if (ACT == 1) {
#pragma unroll
                        for (int e = 0; e < 4; ++e) { const float a = fmaxf(v0[e], 0.f), b = fmaxf(v1[e], 0.f); v0[e] = a * a; v1[e] = b * b; } }
                    *(u32x4*)(rowp + bj * HALF) = pack8(v0, v1); } }
    }
};
struct EpiFft1 {
    static constexpr bool PERM = true, AFTER_DRAIN = false;
    bf16_t* O;
    __device__ __forceinline__ void operator()(const f32x4 (&acc)[2][2][4][2], const Unit& u, int wr, int wc, int fr, int fq) const {
        const int r0 = (u.pm & 1) * BM + wr * 64 + fr, cs = u.pm >> 1; const int col0 = u.pn * BM + wc * 32 + 8 * fq;
#pragma unroll
        for (int ai = 0; ai < 2; ++ai)
#pragma unroll
            for (int m = 0; m < 4; ++m) { bf16_t* rowp = O + ((size_t)(u.z * 512 + r0 + ai * HALF + m * 16) * 2 + cs) * 8192 + col0;
#pragma unroll
                for (int bj = 0; bj < 2; ++bj) *(u32x4*)(rowp + bj * HALF) = pack8(acc[ai][bj][m][0], acc[ai][bj][m][1]); }
    }
};
struct EpiMixB {
    static constexpr bool PERM = true, AFTER_DRAIN = false;
    bf16_t* O;
    __device__ __forceinline__ void operator()(const f32x4 (&acc)[2][2][4][2], const Unit& u, int wr, int wc, int fr, int fq) const {
        const int r0 = wr * 64 + fr; const int col0 = u.pn * BM + wc * 32 + 8 * fq;
#pragma unroll
        for (int ai = 0; ai < 2; ++ai)
#pragma unroll
            for (int m = 0; m < 4; ++m) { bf16_t* rowp = O + (size_t)(32 * (r0 + ai * HALF + m * 16) + u.z) * 4096 + col0;
#pragma unroll
                for (int bj = 0; bj < 2; ++bj) *(u32x4*)(rowp + bj * HALF) = pack8(acc[ai][bj][m][0], acc[ai][bj][m][1]); }
    }
};
constexpr int RC = 256;
__device__ __forceinline__ float lg2_sigmoid(float d) { return -log1pf(__expf(-d)) * 1.44269504089f; }
__device__ __forceinline__ size_t off_qt(int h, int t, int dk) { return ((((size_t)(h * 256 + (t >> 5)) * 16 + (dk >> 4)) * 2 + ((dk >> 3) & 1)) * 32 + (t & 31)) * 8 + (dk & 7); }
__device__ __forceinline__ void tr_store16(PG8_LAS unsigned char* sw, int fr, int fq, const f32x4 (&v)[2][2], float scale, bf16_t* tile0, int ndim) {
    PG8_LAS bf16_t* wp = (PG8_LAS bf16_t*)(sw + ((fr >> 2) & 1) * 16 + (4 * (fr >> 3) + (fr & 3)) * 2);
#pragma unroll
    for (int bj = 0; bj < 2; ++bj)
#pragma unroll
        for (int n = 0; n < 2; ++n)
#pragma unroll
            for (int e = 0; e < 4; ++e) wp[(bj * 32 + fq * 8 + n * 4 + e) * 16] = f2bf1(v[bj][n][e] * scale);
    asm volatile("" ::: "memory");
    const int lane = fq * 16 + fr;
#pragma unroll
    for (int k = 0; k < 2; ++k) { const int q = lane + 64 * k, col = q >> 1, hq = q & 1;
        const u32x4 val = *(const PG8_LAS u32x4*)(sw + q * 16);
        *(u32x4*)(tile0 + ((size_t)hq * ndim + (col >> 5) * 128 + (col & 31)) * 8) = val; }
    asm volatile("" ::: "memory");
}
struct EpiWin {
    static constexpr bool PERM = true, AFTER_DRAIN = false;
    bf16_t *Q0, *K0, *KFT, *KBT, *VT, *SG; const float* decf; const float* decb; int S; PG8_LAS unsigned char* scr;
    __device__ __forceinline__ void operator()(const f32x4 (&acc)[2][2][4][2], const Unit& u, int wr, int wc, int fr, int fq) const {
        const int pn = u.pn; const int rowb = u.pm * BM + wr * 64 + fr; const int cj = wc * 32 + fq * 8;
        PG8_LAS unsigned char* sw = scr + (wr * 4 + wc) * 2048;
        if (pn < 32) {
            const bool isk = pn >= 16; const int h = pn & 15;
            const float lf2 = lg2_sigmoid(decf[h]), lb2 = lg2_sigmoid(decb[h]);
            float inv[8];
#pragma unroll
            for (int e = 0; e < 8; ++e) inv[e] = __builtin_amdgcn_exp2f(-(float)(cj + e) * (13.287712379549449f / 128.f));
#pragma unroll
            for (int ai = 0; ai < 2; ++ai)
#pragma unroll
                for (int m = 0; m < 4; ++m) {
                    const int row = rowb + ai * HALF + m * 16;
                    f32x4 c0, c1, s0, s1;
#pragma unroll
                    for (int e = 0; e < 4; ++e) {
                        const float r0 = __builtin_amdgcn_fractf(((float)row * inv[e]) * 0.15915494309189535f), r1 = __builtin_amdgcn_fractf(((float)row * inv[4 + e]) * 0.15915494309189535f);
                        c0[e] = __builtin_amdgcn_cosf(r0); s0[e] = __builtin_amdgcn_sinf(r0); c1[e] = __builtin_amdgcn_cosf(r1); s1[e] = __builtin_amdgcn_sinf(r1); }
                    const f32x4 x1a = acc[ai][0][m][0], x1b = acc[ai][0][m][1], x2a = acc[ai][1][m][0], x2b = acc[ai][1][m][1];
                    f32x4 o1a = x1a * c0 - x2a * s0, o1b = x1b * c1 - x2b * s1, o2a = x1a * s0 + x2a * c0, o2b = x1b * s1 + x2b * c1;
                    const int jj = row & (RC - 1);
                    const size_t o1 = off_qt(h, row, cj), o2 = off_qt(h, row, 128 + cj);
                    if (!isk) {
                        *(u32x4*)(Q0 + o1) = pack8(o1a, o1b); *(u32x4*)(Q0 + o2) = pack8(o2a, o2b);
                    } else {
                        o1a = o1a * 0.0625f; o1b = o1b * 0.0625f; o2a = o2a * 0.0625f; o2b = o2b * 0.0625f;
                        *(u32x4*)(K0 + o1) = pack8(o1a, o1b); *(u32x4*)(K0 + o2) = pack8(o2a, o2b);
                        const float f = __builtin_amdgcn_exp2f((float)(RC - 1 - jj) * lf2), b = __builtin_amdgcn_exp2f((float)jj * lb2);
                        const int row0 = row - fr;
                        const size_t tb = ((((size_t)(h * 256 + (row0 >> 5)) * 2 + ((row0 >> 4) & 1)) * 2) * 256 + wc * 32) * 8;
                        const f32x4 ov[2][2] = {{o1a, o1b}, {o2a, o2b}};
                        tr_store16(sw, fr, fq, ov, f, KFT + tb, 256);
                        tr_store16(sw, fr, fq, ov, b, KBT + tb, 256);
                    }
                }
        } else if (pn < 64) {
            const int h = (pn - 32) >> 1, dv0 = ((pn - 32) & 1) * 256 + wc * 32;
#pragma unroll
            for (int ai = 0; ai < 2; ++ai)
#pragma unroll
                for (int m = 0; m < 4; ++m) { const int row0 = rowb - fr + ai * HALF + m * 16;
                    const f32x4 ov[2][2] = {{acc[ai][0][m][0], acc[ai][0][m][1]}, {acc[ai][1][m][0], acc[ai][1][m][1]}};
                    tr_store16(sw, fr, fq, ov, 1.0f, VT + ((((size_t)(h * 256 + (row0 >> 5)) * 2 + ((row0 >> 4) & 1)) * 2) * 512 + dv0) * 8, 512); }
        } else {
            const int cb = (pn - 64) * 256 + cj;
#pragma unroll
            for (int ai = 0; ai < 2; ++ai)
#pragma unroll
                for (int m = 0; m < 4; ++m) { bf16_t* rowp = SG + (size_t)(rowb + ai * HALF + m * 16) * 8192 + cb;
#pragma unroll
                    for (int bj = 0; bj < 2; ++bj) { f32x4 v0 = acc[ai][bj][m][0], v1 = acc[ai][bj][m][1];
#pragma unroll
                        for (int e = 0; e < 4; ++e) { v0[e] = v0[e] * __builtin_amdgcn_rcpf(1.f + __expf(-v0[e])); v1[e] = v1[e] * __builtin_amdgcn_rcpf(1.f + __expf(-v1[e])); }
                        *(u32x4*)(rowp + bj * HALF) = pack8(v0, v1); } }
        }
    }
};

template <class Epi, class Sched, bool ALIGN_EPI = false, bool SP2 = false, bool KFIX = false>
__device__ __forceinline__ void gemm_phase(PG8_LAS unsigned char* lds, const Gemm g, const Sched& S, const Epi& E) {
    const int tid = threadIdx.x, wid = __builtin_amdgcn_readfirstlane(tid >> 6), lane = tid & 63, wr = wid >> 2, wc = wid & 3, fr = lane & 15, fq = lane >> 4;
    const int K = g.K, nt = K / BK;
    unsigned voffA[2], voffB[2];
#pragma unroll
    for (int i = 0; i < 2; ++i) { int R, C; stage_rc(tid * 16 + i * 8192, R, C); const int Rb = Epi::PERM ? ((R & ~31) + perm32(R & 31)) : R;
        voffA[i] = (unsigned)(R * g.lda + C) * 2u; voffB[i] = (unsigned)(Rb * g.ldb + C) * 2u; }
    const size_t kstep = KFIX ? (size_t)0 : (size_t)(BK * 2);
    const size_t hstepA = (size_t)HALF * g.lda * 2, hstepB = (size_t)HALF * g.ldb * 2;
    const size_t tstepA = 2 * hstepA, tstepB = 2 * hstepB;
    const unsigned ldsw = (unsigned)wid * 1024u;
    const int aoff = lds_byte(wr * 64 + fr, fq * 8), boff = lds_byte(wc * 32 + fr, fq * 8);
#define PG8_SA(b, h) (((b) * 2 + (h)) * HTB)
#define PG8_SB(b, h) ((4 + (b) * 2 + (h)) * HTB)
#define PG8_STAGE(bufoff, gbase, voff) do { _Pragma("unroll") for (int _i = 0; _i < 2; ++_i) \
        __builtin_amdgcn_global_load_lds((const unsigned*)((const char*)(gbase) + (voff)[_i]), (PG8_LAS unsigned*)(lds + (bufoff) + ldsw + _i * 8192), 16, 0, 0); } while (0)
#define PG8_LDA(dst, b, h) do { _Pragma("unroll") for (int m = 0; m < 4; ++m) _Pragma("unroll") for (int k = 0; k < 2; ++k) dst[m][k] = *(const PG8_LAS bf16x8*)(lds + PG8_SA(b, h) + aoff + m * 2048 + k * 1024); } while (0)
#define PG8_LDB(dst, b, h) do { _Pragma("unroll") for (int n = 0; n < 2; ++n) _Pragma("unroll") for (int k = 0; k < 2; ++k) dst[n][k] = *(const PG8_LAS bf16x8*)(lds + PG8_SB(b, h) + boff + n * 2048 + k * 1024); } while (0)
#define PG8_MMA(ai, bj, At, Bt) do { __builtin_amdgcn_s_setprio(1); _Pragma("unroll") for (int m = 0; m < 4; ++m) _Pragma("unroll") for (int n = 0; n < 2; ++n) _Pragma("unroll") for (int k = 0; k < 2; ++k) \
        acc[ai][bj][m][n] = __builtin_amdgcn_mfma_f32_16x16x32_bf16(Bt[n][k], At[m][k], acc[ai][bj][m][n], 0, 0, 0); __builtin_amdgcn_s_setprio(0); } while (0)
#define PG8_WAIT_V(n) asm volatile("s_waitcnt vmcnt(" #n ")" ::: "memory")
#define PG8_WAIT_L(n) asm volatile("s_waitcnt lgkmcnt(" #n ")" ::: "memory")
#define PG8_BAR __builtin_amdgcn_s_barrier()
#define PG8_SCHED __builtin_amdgcn_sched_barrier(0)
    Unit cur, nxt; int ui = 0;
    if (!S.next(0, cur)) return;
    f32x4 acc[2][2][4][2];
#pragma unroll
    for (int a = 0; a < 2; ++a)
#pragma unroll
        for (int b = 0; b < 2; ++b)
#pragma unroll
            for (int m = 0; m < 4; ++m)
#pragma unroll
                for (int n = 0; n < 2; ++n) acc[a][b][m][n] = (f32x4){0.f, 0.f, 0.f, 0.f};
    bf16x8 At[4][2], B0[2][2], B1[2][2];
    const char* cA = (const char*)(g.A + (size_t)cur.z * g.zA) + (size_t)cur.pm * tstepA; const char* cB = (const char*)(g.Bt + (size_t)cur.z * g.zB) + (size_t)cur.pn * tstepB;
    S.a_ready(cur);
    if constexpr (SP2) {
        PG8_STAGE(PG8_SB(0, 0), cB, voffB); PG8_STAGE(PG8_SB(0, 1), cB + hstepB, voffB); PG8_STAGE(PG8_SA(0, 0), cA, voffA); PG8_STAGE(PG8_SA(0, 1), cA + hstepA, voffA);
        if (wr == 1) PG8_BAR;
        PG8_WAIT_V(2); PG8_BAR;
        PG8_STAGE(PG8_SB(1, 0), cB + kstep, voffB); PG8_STAGE(PG8_SA(1, 0), cA + kstep, voffA); PG8_STAGE(PG8_SB(1, 1), cB + hstepB + kstep, voffB);
        PG8_WAIT_V(6); PG8_BAR;
    } else {
        PG8_STAGE(PG8_SB(0, 0), cB, voffB); PG8_STAGE(PG8_SA(0, 0), cA, voffA); PG8_STAGE(PG8_SB(0, 1), cB + hstepB, voffB); PG8_STAGE(PG8_SA(0, 1), cA + hstepA, voffA);
        if (wr == 1) PG8_BAR;
        PG8_WAIT_V(4); PG8_BAR;
        PG8_STAGE(PG8_SB(1, 0), cB + kstep, voffB); PG8_STAGE(PG8_SA(1, 0), cA + kstep, voffA); PG8_STAGE(PG8_SB(1, 1), cB + hstepB + kstep, voffB);
        PG8_WAIT_V(6); PG8_BAR;
    }
    for (;;) {
        const bool has_next = S.next(ui + 1, nxt);
        const char* nA = has_next ? (const char*)(g.A + (size_t)nxt.z * g.zA) + (size_t)nxt.pm * tstepA : cA; const char* nB = has_next ? (const char*)(g.Bt + (size_t)nxt.z * g.zB) + (size_t)nxt.pn * tstepB : cB;
        for (int t = 0; t < nt; t += 2) {
            const bool last = (t == nt - 2);
            const char* a1 = cA + (size_t)(t + 1) * kstep;
            const char* a2 = last ? nA : cA + (size_t)(t + 2) * kstep; const char* b2 = last ? nB : cB + (size_t)(t + 2) * kstep;
            const char* a3 = a2 + kstep; const char* b3 = b2 + kstep;
            if (last && has_next) S.a_ready(nxt);
            if constexpr (SP2) {
            PG8_LDB(B0, 0, 0); PG8_LDB(B1, 0, 1); PG8_SCHED; PG8_LDA(At, 0, 0); PG8_STAGE(PG8_SA(1, 1), a1 + hstepA, voffA);
            PG8_WAIT_V(8); PG8_WAIT_L(0); PG8_BAR; PG8_MMA(0, 0, At, B0); PG8_MMA(0, 1, At, B1); PG8_BAR; PG8_SCHED;
            PG8_LDA(At, 0, 1); PG8_STAGE(PG8_SB(0, 0), b2, voffB); PG8_STAGE(PG8_SB(0, 1), b2 + hstepB, voffB); PG8_STAGE(PG8_SA(0, 0), a2, voffA);
            PG8_WAIT_V(8); PG8_WAIT_L(0); PG8_BAR; PG8_MMA(1, 0, At, B0); PG8_MMA(1, 1, At, B1); PG8_BAR; PG8_SCHED;
            PG8_LDB(B0, 1, 0); PG8_LDB(B1, 1, 1); PG8_SCHED; PG8_LDA(At, 1, 0); PG8_STAGE(PG8_SA(0, 1), a2 + hstepA, voffA);
            PG8_WAIT_V(8); PG8_WAIT_L(0); PG8_BAR; PG8_MMA(0, 0, At, B0); PG8_MMA(0, 1, At, B1); PG8_BAR; PG8_SCHED;
            PG8_LDA(At, 1, 1); PG8_STAGE(PG8_SB(1, 0), b3, voffB); PG8_STAGE(PG8_SB(1, 1), b3 + hstepB, voffB); PG8_STAGE(PG8_SA(1, 0), a3, voffA);
            PG8_WAIT_V(8); PG8_WAIT_L(0); PG8_BAR; PG8_MMA(1, 0, At, B0); PG8_MMA(1, 1, At, B1); PG8_BAR; PG8_SCHED;
            } else {
            PG8_LDB(B0, 0, 0); PG8_SCHED; PG8_LDA(At, 0, 0); PG8_STAGE(PG8_SA(1, 1), a1 + hstepA, voffA);
            PG8_WAIT_L(8); PG8_BAR; PG8_WAIT_L(0); PG8_MMA(0, 0, At, B0); PG8_BAR; PG8_SCHED;
            PG8_LDB(B1, 0, 1); PG8_STAGE(PG8_SB(0, 0), b2, voffB);
            PG8_BAR; PG8_WAIT_L(0); PG8_MMA(0, 1, At, B1); PG8_BAR;
            PG8_LDA(At, 0, 1); PG8_STAGE(PG8_SA(0, 0), a2, voffA);
            PG8_BAR; PG8_WAIT_L(0); PG8_MMA(1, 0, At, B0); PG8_BAR; PG8_SCHED;
            PG8_STAGE(PG8_SB(0, 1), b2 + hstepB, voffB);
            PG8_WAIT_V(6); PG8_BAR; PG8_MMA(1, 1, At, B1); PG8_BAR;
            PG8_LDB(B0, 1, 0); PG8_SCHED; PG8_LDA(At, 1, 0); PG8_STAGE(PG8_SA(0, 1), a2 + hstepA, voffA);
            PG8_WAIT_L(8); PG8_BAR; PG8_WAIT_L(0); PG8_MMA(0, 0, At, B0); PG8_BAR; PG8_SCHED;
            PG8_LDB(B1, 1, 1); PG8_STAGE(PG8_SB(1, 0), b3, voffB);
            PG8_BAR; PG8_WAIT_L(0); PG8_MMA(0, 1, At, B1); PG8_BAR;
            PG8_LDA(At, 1, 1); PG8_STAGE(PG8_SA(1, 0), a3, voffA);
            PG8_BAR; PG8_WAIT_L(0); PG8_MMA(1, 0, At, B0); PG8_BAR; PG8_SCHED;
            PG8_STAGE(PG8_SB(1, 1), b3 + hstepB, voffB);
            PG8_WAIT_V(6); PG8_BAR; PG8_MMA(1, 1, At, B1); PG8_BAR;
            }
        }
        if constexpr (ALIGN_EPI) { if (wr == 0) PG8_BAR; }
        E(acc, cur, wr, wc, fr, fq); S.done(cur);
        if (!has_next) break;
#pragma unroll
        for (int a = 0; a < 2; ++a)
#pragma unroll
            for (int b = 0; b < 2; ++b)
#pragma unroll
                for (int m = 0; m < 4; ++m)
#pragma unroll
                    for (int n = 0; n < 2; ++n) acc[a][b][m][n] = (f32x4){0.f, 0.f, 0.f, 0.f};
        cur = nxt; cA = nA; cB = nB; ++ui;
        if constexpr (ALIGN_EPI) { if (wr == 1) PG8_BAR; }
    }
    PG8_WAIT_V(0);
    if constexpr (!ALIGN_EPI) { if (wr == 0) PG8_BAR; }
    PG8_BAR;
#undef PG8_SA
#undef PG8_SB
#undef PG8_STAGE
#undef PG8_LDA
#undef PG8_LDB
#undef PG8_MMA
#undef PG8_WAIT_V
#undef PG8_WAIT_L
#undef PG8_BAR
#undef PG8_SCHED
}
}

#ifndef PG8_SP2
#define PG8_SP2 true
#endif
#ifndef PG8_ALIGN
#define PG8_ALIGN true
#endif

constexpr int NWAVES = 8;
constexpr int S_ = 8192, D_ = 4096, H_ = 16, DK = 256, DV = 512, VW = 8192, WIN = 24576, DFF = 16384, NMOD = 6 * D_;
constexpr int NCH = S_ / pg8::RC;
constexpr float EPS_ = 1e-6f;

constexpr size_t MiB = 1u << 20;
constexpr size_t WS_CTL = 0, CTL_ZERO_BYTES = 1 * MiB;
constexpr size_t WS_MOD = 1 * MiB;
constexpr size_t WS_T512 = 2 * MiB;
constexpr size_t WS_WIN = 16 * MiB;
constexpr size_t WS_WOUT = 208 * MiB;
constexpr size_t WS_WF = 272 * MiB;
constexpr size_t WS_W1 = 304 * MiB;
constexpr size_t WS_W2 = 560 * MiB;
constexpr size_t WS_G = 816 * MiB;
constexpr size_t WS_AB = 944 * MiB;
constexpr size_t WS_XN = 1072 * MiB;
constexpr size_t WS_XA = 1136 * MiB;
constexpr size_t WS_Y = 1264 * MiB;
constexpr size_t WS_Q0 = 1328 * MiB, WS_K0 = 1520 * MiB, WS_KFT = 1584 * MiB, WS_KBT = 1648 * MiB;
constexpr size_t WS_VT = 1712 * MiB;
constexpr size_t WS_SG = 1840 * MiB;
constexpr size_t WS_ST = 1968 * MiB;
constexpr size_t WS_A2 = 2224 * MiB;
constexpr size_t WS_HB = WS_Q0;
constexpr size_t WS_YT = WS_KFT;
constexpr size_t WS_MIX = WS_VT;
constexpr size_t WS_END = 2352 * MiB;
static_assert(WS_ST + (size_t)H_ * NCH * 2 * DV * DK * 2 <= WS_A2, "ST fits");
constexpr int CW_TMO = 0, CW_Q = 64;
constexpr int CW_BAR = 4096;
constexpr int RING_OFF = 0, RING_BYTES = 131072;
constexpr int LDSCTL_OFF = 155648, MISC_OFF = LDSCTL_OFF + 320;
constexpr int LDS_BYTES = 163840;

#define GAS __attribute__((address_space(1)))
#define LAS __attribute__((address_space(3)))
typedef unsigned short bf16;
typedef unsigned v4u __attribute__((ext_vector_type(4)));
typedef unsigned v2u __attribute__((ext_vector_type(2)));
typedef float f32x4 __attribute__((ext_vector_type(4)));
typedef float f32x16 __attribute__((ext_vector_type(16)));
typedef short bf16x8 __attribute__((ext_vector_type(8)));
typedef short bf16x4 __attribute__((ext_vector_type(4)));
typedef GAS unsigned gu32;
#define RLX_AGENT __ATOMIC_RELAXED, __HIP_MEMORY_SCOPE_AGENT
#define LDS_WAIT() asm volatile("s_waitcnt lgkmcnt(0)" ::: "memory")
#define VM_WAIT() asm volatile("s_waitcnt vmcnt(0)" ::: "memory")
__device__ __forceinline__ unsigned pk2(float lo, float hi) { return pg8::cvt_pk_bf16(lo, hi); }
__device__ __forceinline__ float bf_lo(unsigned w) { return __builtin_bit_cast(float, w << 16); }
__device__ __forceinline__ float bf_hi(unsigned w) { return __builtin_bit_cast(float, w & 0xffff0000u); }

#define XB_TMO      128
#define XB_XCNT(j)  (256  + 64 * (j))
#define XB_XSUB(j)  (1280 + 64 * (j))
#define XB_XGEN(j)  (2304 + 64 * (j))
#define XB_TOP      3328
#define XB_TOPGEN   3392
#define XCD_BAR_WORDS 3456
#define XB_SPIN_CAP (1u << 18)
__device__ __forceinline__ unsigned xb_ld(unsigned* p)              { return __hip_atomic_load(p, __ATOMIC_RELAXED, __HIP_MEMORY_SCOPE_AGENT); }
__device__ __forceinline__ unsigned xb_add(unsigned* p, unsigned v) { return __hip_atomic_fetch_add(p, v, __ATOMIC_RELAXED, __HIP_MEMORY_SCOPE_AGENT); }
__device__ __forceinline__ unsigned xb_xcc_id() { return (unsigned)__builtin_amdgcn_s_getreg((3 << 11) | 20) & 0xFu; }
#define XB_SPIN(cond, bar) do { unsigned _sp = 0; while (cond) { __builtin_amdgcn_s_sleep(1); \
    if ((++_sp & 255u) == 0u) { if (xb_ld(&(bar)[XB_TMO])) break; if (_sp > XB_SPIN_CAP) { atomicAdd(&(bar)[XB_TMO], 1u); break; } } } } while (0)
struct XcdBarrier { unsigned* bar; unsigned x; volatile LAS unsigned* st; };
__device__ __forceinline__ XcdBarrier xcd_barrier_post(unsigned* bar, volatile LAS unsigned* st) {
    XcdBarrier b; b.bar = bar; b.x = xb_xcc_id(); b.st = st;
    if (threadIdx.x == 0) (void)xb_add(&bar[XB_XCNT(b.x)], 1u);
    return b;
}
__device__ __forceinline__ void xcd_barrier_complete(unsigned* bar, unsigned x, unsigned& nloc, unsigned& nx) {
    const unsigned G = gridDim.x * gridDim.y * gridDim.z;
    unsigned sum, cnt, mine, sp = 0u;
    for (;;) {
        sum = 0u; cnt = 0u; mine = 0u;
#pragma unroll
        for (unsigned j = 0; j < 16; ++j) { const unsigned c = xb_ld(&bar[XB_XCNT(j)]); sum += c; cnt += (c > 0u) ? 1u : 0u; mine = (j == x) ? c : mine; }
        if (sum == G) break;
        __builtin_amdgcn_s_sleep(1);
        if ((++sp & 255u) == 0u) { if (xb_ld(&bar[XB_TMO])) break; if (sp > XB_SPIN_CAP) { atomicAdd(&bar[XB_TMO], 1u); break; } }
    }
    nloc = mine > 0u ? mine : 1u; nx = cnt > 0u ? cnt : 1u;
}
__device__ __forceinline__ void xcd_barrier(const XcdBarrier& b) {
    asm volatile("s_waitcnt vmcnt(0)" ::: "memory");
    __syncthreads();
    if (threadIdx.x == 0) {
        unsigned* bar = b.bar;
        __builtin_amdgcn_s_waitcnt(0);
        unsigned nloc = b.st[0], nx = b.st[1];
        if (nloc == 0u) { xcd_barrier_complete(bar, b.x, nloc, nx); b.st[0] = nloc; b.st[1] = nx; }
        const unsigned old = xb_add(&bar[XB_XSUB(b.x)], 1u);
        const unsigned gen = old / nloc;
        if (old + 1u == (gen + 1u) * nloc) {
            __builtin_amdgcn_fence(__ATOMIC_RELEASE, "agent");
            asm volatile("s_waitcnt vmcnt(0)" ::: "memory");
            __builtin_amdgcn_fence(__ATOMIC_ACQUIRE, "agent");
            const unsigned og = xb_add(&bar[XB_TOP], 1u);
            const unsigned tg = og / nx;
            if (og + 1u == (tg + 1u) * nx) xb_add(&bar[XB_TOPGEN], 1u);
            else XB_SPIN(xb_ld(&bar[XB_TOPGEN]) == tg, bar);
            asm volatile("" ::: "memory");
            xb_add(&bar[XB_XGEN(b.x)], 1u);
            asm volatile("s_waitcnt vmcnt(0)" ::: "memory");
        } else {
            __builtin_amdgcn_fence(__ATOMIC_ACQUIRE, "agent");
            XB_SPIN(xb_ld(&bar[XB_XGEN(b.x)]) == gen, bar);
            asm volatile("s_waitcnt vmcnt(0)" ::: "memory");
        }
    }
    __syncthreads();
}

struct Args { const float* in[14]; float* out; unsigned char* ws; int ph_lo, ph_hi, li, pad; };
struct Frame {
    LAS unsigned char* lds; volatile LAS unsigned* MISC; unsigned* ctl;
    int tid, wave, G, bid;
    const float *x, *c, *ada_w, *ada_b, *norm_g, *w_in, *w_out, *gn_g, *decf, *decb, *fno_w, *fno_b, *w1, *w2; float* out;
    unsigned char* ws;
};
__device__ __forceinline__ float wave_sum(float v) {
#pragma unroll
    for (int o = 1; o < 64; o <<= 1) v += __shfl_xor(v, o);
    return v;
}

struct TrSub { float v[32]; };
__device__ __forceinline__ void tr_load(TrSub& t, const float* W, int N, int k0, int n0, int lane) {
    const float* p = W + (size_t)(k0 + (lane >> 5)) * N + n0 + (lane & 31);
#pragma unroll
    for (int i = 0; i < 32; ++i) t.v[i] = __builtin_nontemporal_load(p + (size_t)(2 * i) * N);
}
__device__ __forceinline__ void tr_store(const TrSub& t, int K, bf16* WT, int k0, int n0, LAS float* scr, int lane) {
#pragma unroll
    for (int i = 0; i < 32; ++i) scr[(2 * i + (lane >> 5)) * 33 + (lane & 31)] = t.v[i];
    LDS_WAIT(); asm volatile("" ::: "memory");
    const int c = lane & 7;
#pragma unroll
    for (int j = 0; j < 4; ++j) { const int n = (lane >> 3) + 8 * j; const LAS float* s = scr + (8 * c) * 33 + n;
        v4u o; o.x = pk2(s[0 * 33], s[1 * 33]); o.y = pk2(s[2 * 33], s[3 * 33]); o.z = pk2(s[4 * 33], s[5 * 33]); o.w = pk2(s[6 * 33], s[7 * 33]);
        *(GAS v4u*)(WT + (size_t)(n0 + n) * K + k0 + 8 * c) = o; }
    LDS_WAIT(); asm volatile("" ::: "memory");
}
__device__ __forceinline__ void tr_item(const float* W, bf16* WT, int K, int N, int it, LAS float* scr, int wave, int lane) {
    const int nb = N / 256, k0 = (it / nb) * 256, nn = (it % nb) * 256 + wave * 32;
    TrSub ta, tb;
    tr_load(ta, W, N, k0, nn, lane);
    tr_load(tb, W, N, k0 + 64, nn, lane);
    tr_store(ta, K, WT, k0, nn, scr, lane);
    tr_load(ta, W, N, k0 + 128, nn, lane);
    tr_store(tb, K, WT, k0 + 64, nn, scr, lane);
    tr_load(tb, W, N, k0 + 192, nn, lane);
    tr_store(ta, K, WT, k0 + 128, nn, scr, lane);
    tr_store(tb, K, WT, k0 + 192, nn, scr, lane);
}
constexpr int PI_GEMV = 2 * (NMOD / 256);
constexpr int PI_TWIN = (D_ / 256) * (WIN / 256), PI_TWOUT = (VW / 256) * (D_ / 256), PI_TWF = (D_ / 256) * (D_ / 256), PI_TW1 = (D_ / 256) * (DFF / 256), PI_TW2 = (DFF / 256) * (D_ / 256);
constexpr int PI_TR = PI_TWIN;
constexpr int PI_DFT = 4, PI_T512 = 8;
constexpr int PI_TOTAL = PI_GEMV + PI_TR + PI_DFT + PI_T512;
__device__ __forceinline__ float cos_rev(float r) { return __builtin_amdgcn_cosf(r); }
__device__ __forceinline__ float sin_rev(float r) { return __builtin_amdgcn_sinf(r); }

__device__ __forceinline__ void p0_prologue(Frame& F, const int qword) {
    int tid = F.tid; asm volatile("" : "+v"(tid)); const int lane = tid & 63;
    LAS float* sc = (LAS float*)(F.lds);
    LAS float* red = (LAS float*)(F.lds + 16384);
    LAS float* scr = (LAS float*)(F.lds + 32768 + F.wave * 8704);
    for (int i = tid; i < D_; i += NWAVES * 64) { const float v = F.c[i]; sc[i] = v / (1.f + __expf(-v)); }
    __syncthreads();
    for (;;) {
        if (tid == 0) F.MISC[0] = __hip_atomic_fetch_add(F.ctl + qword, 1u, RLX_AGENT);
        __syncthreads();
        int it = (int)F.MISC[0];
        __syncthreads();
        if (it >= PI_TOTAL) break;
        if (it < PI_GEMV) {
            const int l = it / (NMOD / 256), n0 = (it % (NMOD / 256)) * 256;
            const float* W = F.ada_w + (size_t)l * D_ * NMOD + n0 + 4 * lane;
            f32x4 a = {0.f, 0.f, 0.f, 0.f};
            const int kb = F.wave * 512;
            for (int k = 0; k < 512; k += 8) {
                f32x4 w[8];
#pragma unroll
                for (int j = 0; j < 8; ++j) w[j] = __builtin_nontemporal_load((const f32x4*)(W + (size_t)(kb + k + j) * NMOD));
#pragma unroll
                for (int j = 0; j < 8; ++j) a += w[j] * sc[kb + k + j];
            }
            *(LAS f32x4*)(red + F.wave * 256 + 4 * lane) = a;
            __syncthreads();
            if (tid < 256) { float s = 0.f;
#pragma unroll
                for (int w = 0; w < 8; ++w) s += red[w * 256 + tid];
                ((float*)(F.ws + WS_MOD))[(size_t)l * NMOD + n0 + tid] = s + F.ada_b[(size_t)l * NMOD + n0 + tid]; }
            __syncthreads();
            continue;
        }
        it -= PI_GEMV;
        if (it < PI_TR) {
            const float* W; bf16* WT; int K, N;
            W = F.w_in; WT = (bf16*)(F.ws + WS_WIN); K = D_; N = WIN;
            tr_item(W, WT, K, N, it, scr, F.wave, lane);
            continue;
        }
        it -= PI_TR;
        if (it < PI_DFT) {
            bf16* Am = (bf16*)(F.ws + WS_AB);
            for (int i = tid; i < 64 * 512; i += NWAVES * 64) {
                const int r = 64 * it + (i >> 9), k = i & 511;
                const float rev = (float)(((k & 255) * r) & 255) * (1.f / 256.f);
                Am[(size_t)r * 512 + k] = pg8::f2bf1((k >> 8) ? sin_rev(rev) : cos_rev(rev));
            }
            continue;
        }
        it -= PI_DFT;
        {
            bf16* T = (bf16*)(F.ws + WS_T512);
            for (int i = tid; i < 128 * 512; i += NWAVES * 64) {
                const int r = 128 * it + (i >> 9), j = i & 511, cs = r >> 9, jp = r & 511;
                const float rev = (float)((j * jp) & 511) * (1.f / 512.f);
                T[(size_t)r * 512 + j] = pg8::f2bf1(cs ? sin_rev(rev) : cos_rev(rev));
            }
        }
    }
}

__device__ __forceinline__ void conv_phase(Frame& F, const float* W, bf16* WT, int K, int N, int nitems, int qword) {
    int tid = F.tid; asm volatile("" : "+v"(tid)); const int lane = tid & 63;
    LAS float* scr = (LAS float*)(F.lds + 32768 + F.wave * 8704);
    for (;;) {
        if (tid == 0) F.MISC[0] = __hip_atomic_fetch_add(F.ctl + qword, 1u, RLX_AGENT);
        __syncthreads();
        const int it = (int)F.MISC[0];
        __syncthreads();
        if (it >= nitems) break;
        tr_item(W, WT, K, N, it, scr, F.wave, lane);
    }
    __syncthreads();
}

template <int MODE, bool XBF>
__device__ __forceinline__ void norm_phase(Frame& F, const void* xin_, const bf16* y, void* xo_, bf16* xn, const float* gate, const float* gy, const float* gn, const float* sc, const float* sh) {
    const int gw = F.bid * NWAVES + F.wave, NGW = F.G * NWAVES;
    int tid = F.tid; asm volatile("" : "+v"(tid)); const int lane = tid & 63;
    LAS float* L = (LAS float*)F.lds;
    for (int i = tid; i < D_; i += NWAVES * 64) {
        if (MODE >= 1) { L[i] = gate[i]; L[D_ + i] = gy[i]; }
        if (MODE <= 1) { L[2 * D_ + i] = gn[i]; L[3 * D_ + i] = sc[i] + 1.0f; L[4 * D_ + i] = sh[i]; }
    }
    __syncthreads();
    const LAS float* Ll = L + 8 * lane;
#define NP_UNPK(pk_, o_) do { (o_)[0] = bf_lo((pk_).x); (o_)[1] = bf_hi((pk_).x); (o_)[2] = bf_lo((pk_).y); (o_)[3] = bf_hi((pk_).y); (o_)[4] = bf_lo((pk_).z); (o_)[5] = bf_hi((pk_).z); (o_)[6] = bf_lo((pk_).w); (o_)[7] = bf_hi((pk_).w); } while (0)
#pragma unroll 1
    for (int row = gw; row < S_; row += NGW) {
        const size_t ro = (size_t)row * D_ + 8 * lane;
        float xv[8][8];
        if (XBF) {
            v4u xp[8];
#pragma unroll
            for (int k = 0; k < 8; ++k) xp[k] = *(const GAS v4u*)((const bf16*)xin_ + ro + 512 * k);
#pragma unroll
            for (int k = 0; k < 8; ++k) NP_UNPK(xp[k], xv[k]);
        } else {
#pragma unroll
            for (int k = 0; k < 8; ++k) { const f32x4 a = *(const GAS f32x4*)((const float*)xin_ + ro + 512 * k), b = *(const GAS f32x4*)((const float*)xin_ + ro + 512 * k + 4);
                xv[k][0] = a.x; xv[k][1] = a.y; xv[k][2] = a.z; xv[k][3] = a.w; xv[k][4] = b.x; xv[k][5] = b.y; xv[k][6] = b.z; xv[k][7] = b.w; }
        }
        if (MODE >= 1) {
            v4u yp[8]; float ss = 0.f;
#pragma unroll
            for (int k = 0; k < 8; ++k) yp[k] = *(const GAS v4u*)(y + ro + 512 * k);
#pragma unroll
            for (int k = 0; k < 8; ++k) { float t[8]; NP_UNPK(yp[k], t); ss += ((t[0] * t[0] + t[1] * t[1]) + (t[2] * t[2] + t[3] * t[3])) + ((t[4] * t[4] + t[5] * t[5]) + (t[6] * t[6] + t[7] * t[7])); }
            const float rs = 1.0f / sqrtf(wave_sum(ss) * (1.f / D_) + EPS_);
#pragma unroll
            for (int k = 0; k < 8; ++k) asm volatile("" : "+v"(yp[k].x), "+v"(yp[k].y), "+v"(yp[k].z), "+v"(yp[k].w));
#pragma unroll
            for (int k = 0; k < 8; ++k) {
                const f32x4 g0 = *(const LAS f32x4*)(Ll + 512 * k), g1 = *(const LAS f32x4*)(Ll + 512 * k + 4), w0 = *(const LAS f32x4*)(Ll + D_ + 512 * k), w1 = *(const LAS f32x4*)(Ll + D_ + 512 * k + 4);
                const float gg[8] = {g0.x, g0.y, g0.z, g0.w, g1.x, g1.y, g1.z, g1.w}, ww[8] = {w0.x, w0.y, w0.z, w0.w, w1.x, w1.y, w1.z, w1.w};
                float t[8]; NP_UNPK(yp[k], t);
#pragma unroll
                for (int e = 0; e < 8; ++e) xv[k][e] = xv[k][e] + gg[e] * ((t[e] * rs) * ww[e]);
                if (MODE == 2) { *(GAS f32x4*)((float*)xo_ + ro + 512 * k) = (f32x4){xv[k][0], xv[k][1], xv[k][2], xv[k][3]}; *(GAS f32x4*)((float*)xo_ + ro + 512 * k + 4) = (f32x4){xv[k][4], xv[k][5], xv[k][6], xv[k][7]}; }
                else { v4u o; o.x = pk2(xv[k][0], xv[k][1]); o.y = pk2(xv[k][2], xv[k][3]); o.z = pk2(xv[k][4], xv[k][5]); o.w = pk2(xv[k][6], xv[k][7]); *(GAS v4u*)((bf16*)xo_ + ro + 512 * k) = o; }
                if ((k & 1) == 1) __builtin_amdgcn_sched_barrier(0); }
        }
        if (MODE <= 1) {
            float ss = 0.f;
#pragma unroll
            for (int k = 0; k < 8; ++k) ss += ((xv[k][0] * xv[k][0] + xv[k][1] * xv[k][1]) + (xv[k][2] * xv[k][2] + xv[k][3] * xv[k][3])) + ((xv[k][4] * xv[k][4] + xv[k][5] * xv[k][5]) + (xv[k][6] * xv[k][6] + xv[k][7] * xv[k][7]));
            const float rs = 1.0f / sqrtf(wave_sum(ss) * (1.f / D_) + EPS_);
#pragma unroll
            for (int k = 0; k < 8; ++k) {
                float h[8];
#pragma unroll
                for (int q = 0; q < 2; ++q) { const f32x4 w = *(const LAS f32x4*)(Ll + 2 * D_ + 512 * k + 4 * q), a = *(const LAS f32x4*)(Ll + 3 * D_ + 512 * k + 4 * q), b = *(const LAS f32x4*)(Ll + 4 * D_ + 512 * k + 4 * q);
                    h[4 * q] = ((xv[k][4 * q] * rs) * w.x) * a.x + b.x; h[4 * q + 1] = ((xv[k][4 * q + 1] * rs) * w.y) * a.y + b.y; h[4 * q + 2] = ((xv[k][4 * q + 2] * rs) * w.z) * a.z + b.z; h[4 * q + 3] = ((xv[k][4 * q + 3] * rs) * w.w) * a.w + b.w; }
                v4u o; o.x = pk2(h[0], h[1]); o.y = pk2(h[2], h[3]); o.z = pk2(h[4], h[5]); o.w = pk2(h[6], h[7]); *(GAS v4u*)(xn + ro + 512 * k) = o;
                if ((k & 1) == 1) __builtin_amdgcn_sched_barrier(0); }
        }
    }
#undef NP_UNPK
    __syncthreads();
}

template <int NB> __device__ __forceinline__ void dma_blocks(const void* gsrc, LAS unsigned char* ldst, int tid, int wave) {
#pragma unroll
    for (int i = 0; i < NB; ++i) __builtin_amdgcn_global_load_lds((const unsigned*)((const char*)gsrc + i * 8192 + tid * 16), (LAS unsigned*)(ldst + i * 8192 + wave * 1024), 16, 0, 0);
}
#define STAGE_SYNC() do { asm volatile("s_waitcnt vmcnt(0) lgkmcnt(0)" ::: "memory"); __builtin_amdgcn_s_barrier(); asm volatile("" ::: "memory"); } while (0)

__device__ __forceinline__ void rs_phase(Frame& F) {
    const bf16* KFT = (const bf16*)(F.ws + WS_KFT); const bf16* KBT = (const bf16*)(F.ws + WS_KBT); const bf16* VT = (const bf16*)(F.ws + WS_VT); bf16* ST = (bf16*)(F.ws + WS_ST);
    int tid = F.tid; asm volatile("" : "+v"(tid)); const int lane = tid & 63;
    const int r = lane & 31, hh = lane >> 5, w = F.wave, wa = w >> 1, wb = w & 1;
    LAS unsigned char* L = F.lds;
    constexpr int SB = 32768;
    const unsigned aoff = (unsigned)(hh * 2048 + (32 * wa + r) * 16);
    const unsigned boff = (unsigned)(16384 + hh * 2048 + (64 * wb + r) * 16);
    const int vb = (F.G % 8 == 0) ? (F.bid % 8) * (F.G / 8) + F.bid / 8 : F.bid;
    for (int job = vb; job < H_ * 2 * 2 * 4; job += F.G) {
        const int h = job >> 4, d = (job >> 3) & 1, dh = (job >> 2) & 1, e = job & 3;
        const float l2 = pg8::lg2_sigmoid(d ? F.decb[h] : F.decf[h]);
        const float cdec = __builtin_amdgcn_exp2f((float)pg8::RC * l2);
        f32x16 acc[2];
#pragma unroll
        for (int t = 0; t < 2; ++t)
#pragma unroll
            for (int i = 0; i < 16; ++i) acc[t][i] = 0.f;
        const bf16* KT = d ? KBT : KFT;
        const int pidx = ((w >> 2) * 2 + ((w >> 1) & 1)) * 2 + (w & 1);
        const size_t kpiece = ((size_t)pidx * 256 + 128 * dh + lane) * 8, vpiece = ((size_t)pidx * 512 + 128 * e + lane) * 8;
#define RS_ISSUE(step_, sub_, buf_) do { const int c_ = d ? (NCH - 1 - (step_)) : (step_); const size_t tb_ = (size_t)(h * 256 + c_ * 8 + 2 * (sub_)); \
        LAS unsigned char* lb_ = L + (buf_) * SB + w * 2048; \
        __builtin_amdgcn_global_load_lds((const unsigned*)(KT + tb_ * 8192 + kpiece), (LAS unsigned*)(lb_), 16, 0, 0); \
        __builtin_amdgcn_global_load_lds((const unsigned*)(KT + tb_ * 8192 + kpiece + 512), (LAS unsigned*)(lb_ + 1024), 16, 0, 0); \
        __builtin_amdgcn_global_load_lds((const unsigned*)(VT + tb_ * 16384 + vpiece), (LAS unsigned*)(lb_ + 16384), 16, 0, 0); \
        __builtin_amdgcn_global_load_lds((const unsigned*)(VT + tb_ * 16384 + vpiece + 512), (LAS unsigned*)(lb_ + 16384 + 1024), 16, 0, 0); } while (0)
        RS_ISSUE(0, 0, 0); RS_ISSUE(0, 1, 1);
        int bcur = 0;
#pragma unroll 1
        for (int step = 0; step < NCH; ++step) {
            const int c = d ? (NCH - 1 - step) : step;
#pragma unroll
            for (int sub = 0; sub < 4; ++sub) {
                if (step == NCH - 1 && sub == 3) asm volatile("s_waitcnt vmcnt(0) lgkmcnt(0)" ::: "memory"); else asm volatile("s_waitcnt vmcnt(4) lgkmcnt(0)" ::: "memory");
                __builtin_amdgcn_s_barrier(); asm volatile("" ::: "memory");
                { const int bn = bcur >= 1 ? bcur - 1 : 2;
                  if (sub < 2) RS_ISSUE(step, sub + 2, bn); else if (step + 1 < NCH) RS_ISSUE(step + 1, sub - 2, bn); }
                if (sub == 0) {
                    bf16* so = ST + ((((size_t)((h * NCH + c) * 2 + d) * 8 + 4 * dh + wa) * 4) * 512 + 128 * e + 64 * wb + r) * 8 + 4 * hh;
#pragma unroll
                    for (int t = 0; t < 2; ++t)
#pragma unroll
                        for (int g4 = 0; g4 < 4; ++g4) { v2u o; o.x = pk2(acc[t][4 * g4], acc[t][4 * g4 + 1]); o.y = pk2(acc[t][4 * g4 + 2], acc[t][4 * g4 + 3]);
                            *(GAS v2u*)(so + ((size_t)g4 * 512 + 32 * t) * 8) = o; }
#pragma unroll
                    for (int t = 0; t < 2; ++t)
#pragma unroll
                        for (int i = 0; i < 16; ++i) acc[t][i] *= cdec;
                }
                const LAS unsigned char* B = L + bcur * SB;
#pragma unroll
                for (int kbi = 0; kbi < 2; ++kbi)
#pragma unroll
                    for (int s2 = 0; s2 < 2; ++s2) {
                        const bf16x8 a = *(const LAS bf16x8*)(B + aoff + (kbi * 2 + s2) * 4096);
                        const bf16x8 b0 = *(const LAS bf16x8*)(B + boff + (kbi * 2 + s2) * 4096), b1 = *(const LAS bf16x8*)(B + boff + (kbi * 2 + s2) * 4096 + 512);
                        acc[0] = __builtin_amdgcn_mfma_f32_32x32x16_bf16(a, b0, acc[0], 0, 0, 0);
                        acc[1] = __builtin_amdgcn_mfma_f32_32x32x16_bf16(a, b1, acc[1], 0, 0, 0);
                    }
                bcur = bcur == 2 ? 0 : bcur + 1;
            }
        }
#undef RS_ISSUE
        asm volatile("s_waitcnt lgkmcnt(0)" ::: "memory"); __builtin_amdgcn_s_barrier(); asm volatile("" ::: "memory");
    }
}

__device__ __forceinline__ void r3_phase(Frame& F) {
    const bf16* Q0 = (const bf16*)(F.ws + WS_Q0); const bf16* K0 = (const bf16*)(F.ws + WS_K0);
    const bf16* VT = (const bf16*)(F.ws + WS_VT); const bf16* ST = (const bf16*)(F.ws + WS_ST); const bf16* SG = (const bf16*)(F.ws + WS_SG); bf16* A2 = (bf16*)(F.ws + WS_A2);
    LAS unsigned char* L = F.lds;
    constexpr int QL = 98304, NQL = 12, NGR = 56, NSLOT = 6, AHEAD = 5;
    LAS float* red = (LAS float*)(F.lds + 147456);
    LAS float* gnl = (LAS float*)(F.lds + 149504);
    int tid = F.tid; asm volatile("" : "+v"(tid)); const int lane = tid & 63;
    const int r = lane & 31, hh = lane >> 5, w = F.wave, wr = w >> 1, wc = w & 1;
    const unsigned koff = (unsigned)(hh * 512 + r * 16);
    const unsigned voff = (unsigned)(hh * 8192 + wc * 4096 + r * 16);
    const unsigned qoff = (unsigned)(QL + wr * (NQL * 1024) + hh * 512 + r * 16);
    const int NU = H_ * (S_ / 128);
#define R3_GRAN(uu_, n_, sl_) do { const int hq_ = (uu_) >> 6, cq_ = ((uu_) & 63) >> 1; const bf16* src_; \
        if ((n_) < 32) { const int d_ = 1 - ((n_) >> 4), s8_ = ((n_) >> 1) & 7; src_ = ST + ((size_t)((hq_ * NCH + cq_) * 2 + d_) * 8 + s8_) * 16384 + ((n_) & 1) * 8192; } \
        else { const int m_ = (n_) - 32, kb_ = m_ / 3, pt_ = m_ - 3 * kb_; const size_t tb_ = (size_t)(hq_ * 256 + cq_ * 8 + kb_); src_ = pt_ == 0 ? K0 + tb_ * 8192 : VT + tb_ * 16384 + (pt_ - 1) * 8192; } \
        dma_blocks<2>(src_, L + (sl_) * 16384, tid, w); } while (0)
#define R3_ISSUE_Q(uu_) do { _Pragma("unroll") for (int p_ = 0; p_ < 6; ++p_) { const int pc_ = 6 * w + p_, g_ = pc_ / NQL, i_ = pc_ % NQL; \
        __builtin_amdgcn_global_load_lds((const unsigned*)(Q0 + ((size_t)(((uu_) >> 6) * 256 + ((uu_) & 63) * 4 + g_) * 16 + i_) * 512 + lane * 8), (LAS unsigned*)(L + QL + g_ * (NQL * 1024) + i_ * 1024), 16, 0, 0); } } while (0)
#define R3_STEP(n_, drain_) do { if (drain_) asm volatile("s_waitcnt vmcnt(0) lgkmcnt(0)" ::: "memory"); else asm volatile("s_waitcnt vmcnt(8) lgkmcnt(0)" ::: "memory"); \
        __builtin_amdgcn_s_barrier(); asm volatile("" ::: "memory"); \
        { const int gi_ = (n_) + AHEAD; const int fs_ = slot == 0 ? NSLOT - 1 : slot - 1; \
          if (gi_ < NGR) R3_GRAN(u, gi_, fs_); else if (has_next) R3_GRAN(u + F.G, gi_ - NGR, fs_); } } while (0)
    int u = (F.G % 8 == 0) ? (F.bid % 8) * (F.G / 8) + F.bid / 8 : F.bid;
    int slot = 0;
    if (u < NU) {
#pragma unroll
        for (int g = 0; g < AHEAD; ++g) R3_GRAN(u, g, g);
        R3_ISSUE_Q(u);
    }
#pragma unroll 1
    for (; u < NU; u += F.G) {
        const int h = u >> 6, qb = u & 63;
        const int tq = qb * 128 + 32 * wr + r, jq = tq & (pg8::RC - 1);
        const bool has_next = (u + F.G) < NU;
        const float lf2 = pg8::lg2_sigmoid(F.decf[h]), lb2 = pg8::lg2_sigmoid(F.decb[h]);
        const size_t qfo = ((size_t)(h * 256 + qb * 4 + wr) * 1024 + hh * 32 + r) * 8;
        bf16x8 qr[16 - NQL];
#pragma unroll
        for (int i = 0; i < 16 - NQL; ++i) qr[i] = *(const GAS bf16x8*)(Q0 + qfo + (NQL + i) * 512);
        f32x16 acc[8];
#pragma unroll
        for (int t = 0; t < 8; ++t)
#pragma unroll
            for (int i = 0; i < 16; ++i) acc[t][i] = 0.f;
        const float qfs = __builtin_amdgcn_exp2f((float)(jq + 1) * lf2), qbs = __builtin_amdgcn_exp2f((float)(pg8::RC - jq) * lb2);
#pragma unroll 1
        for (int dd = 0; dd < 2; ++dd) {
#pragma unroll
            for (int sl = 0; sl < 8; ++sl)
#pragma unroll
                for (int k2 = 0; k2 < 2; ++k2) {
                    const int n = dd * 16 + sl * 2 + k2;
                    R3_STEP(n, n == 0);
                    const LAS unsigned char* B = L + slot * 16384;
                    const int ks = 2 * sl + k2;
                    bf16x8 qv; if (ks < NQL) qv = *(const LAS bf16x8*)(L + qoff + ks * 1024); else qv = qr[ks < NQL ? 0 : ks - NQL];
#pragma unroll
                    for (int t = 0; t < 8; ++t) { const bf16x8 a = *(const LAS bf16x8*)(B + voff + t * 512);
                        acc[t] = __builtin_amdgcn_mfma_f32_32x32x16_bf16(a, qv, acc[t], 0, 0, 0); if ((t & 3) == 3) __builtin_amdgcn_sched_barrier(0); }
                    slot = slot == NSLOT - 1 ? 0 : slot + 1;
                }
            const float scl = dd == 0 ? qbs / qfs : qfs;
#pragma unroll
            for (int t = 0; t < 8; ++t)
#pragma unroll
                for (int i = 0; i < 16; ++i) acc[t][i] *= scl;
        }
#pragma unroll 1
        for (int kb = 0; kb < 8; ++kb) {
            const int n0 = 32 + 3 * kb;
            const bool tail = !has_next && n0 + 2 + (AHEAD - 1) >= NGR;
            R3_STEP(n0, tail);
            bf16x8 pf[2];
            {
                const LAS unsigned char* B = L + slot * 16384;
                f32x16 sc;
#pragma unroll
                for (int i = 0; i < 16; ++i) sc[i] = 0.f;
#pragma unroll
                for (int ks = 0; ks < NQL; ++ks) { const bf16x8 a = *(const LAS bf16x8*)(B + koff + ks * 1024), b = *(const LAS bf16x8*)(L + qoff + ks * 1024);
                    sc = __builtin_amdgcn_mfma_f32_32x32x16_bf16(a, b, sc, 0, 0, 0); if ((ks & 1) == 1) __builtin_amdgcn_sched_barrier(0); }
#pragma unroll
                for (int ks = NQL; ks < 16; ++ks) { const bf16x8 a = *(const LAS bf16x8*)(B + koff + ks * 1024); sc = __builtin_amdgcn_mfma_f32_32x32x16_bf16(a, qr[ks - NQL], sc, 0, 0, 0); }
#pragma unroll
                for (int i = 0; i < 16; ++i) { const int jm = 32 * kb + (i & 3) + 8 * (i >> 2) + 4 * hh; const int df = jq - jm;
                    const float dm = df > 0 ? __builtin_amdgcn_exp2f((float)df * lf2) : (df < 0 ? __builtin_amdgcn_exp2f((float)(-df) * lb2) : 2.0f); sc[i] *= dm; }
#pragma unroll
                for (int s2 = 0; s2 < 2; ++s2) { v4u p; p.x = pk2(sc[8 * s2], sc[8 * s2 + 1]); p.y = pk2(sc[8 * s2 + 2], sc[8 * s2 + 3]); p.z = pk2(sc[8 * s2 + 4], sc[8 * s2 + 5]); p.w = pk2(sc[8 * s2 + 6], sc[8 * s2 + 7]); pf[s2] = __builtin_bit_cast(bf16x8, p); }
                slot = slot == NSLOT - 1 ? 0 : slot + 1;
            }
#pragma unroll
            for (int s2 = 0; s2 < 2; ++s2) {
                R3_STEP(n0 + 1 + s2, tail);
                const LAS unsigned char* B = L + slot * 16384;
#pragma unroll
                for (int t = 0; t < 8; ++t) { const bf16x8 av = *(const LAS bf16x8*)(B + voff + t * 512);
                    acc[t] = __builtin_amdgcn_mfma_f32_32x32x16_bf16(av, pf[s2], acc[t], 0, 0, 0); if ((t & 3) == 3) __builtin_amdgcn_sched_barrier(0); }
                slot = slot == NSLOT - 1 ? 0 : slot + 1;
            }
        }
        const int cb = h * DV + 256 * wc + 4 * hh;
        const bf16* sg = SG + (size_t)tq * VW + cb; bf16* ao = A2 + (size_t)tq * VW + cb;
        v2u gwv[32];
#pragma unroll
        for (int t = 0; t < 8; ++t)
#pragma unroll
            for (int g4 = 0; g4 < 4; ++g4) gwv[4 * t + g4] = *(const GAS v2u*)(sg + 32 * t + 8 * g4);
        gnl[tid] = F.gn_g[h * DV + tid];
        float s1 = 0.f;
#pragma unroll
        for (int t = 0; t < 8; ++t)
#pragma unroll
            for (int i = 0; i < 16; ++i) s1 += acc[t][i];
        s1 += __shfl_xor(s1, 32);
        if (hh == 0) red[(wr * 2 + wc) * 32 + r] = s1;
        __syncthreads();
        if (has_next) R3_ISSUE_Q(u + F.G);
        const float mean = (red[(wr * 2) * 32 + r] + red[(wr * 2 + 1) * 32 + r]) * (1.f / DV);
        float s2 = 0.f;
#pragma unroll
        for (int t = 0; t < 8; ++t)
#pragma unroll
            for (int i = 0; i < 16; ++i) { const float dlt = acc[t][i] - mean; s2 += dlt * dlt; }
        s2 += __shfl_xor(s2, 32);
        if (hh == 0) red[256 + (wr * 2 + wc) * 32 + r] = s2;
        __syncthreads();
        const float rstd = 1.0f / sqrtf((red[256 + (wr * 2) * 32 + r] + red[256 + (wr * 2 + 1) * 32 + r]) * (1.f / DV) + EPS_);
        const LAS float* gg = gnl + 256 * wc + 4 * hh;
#pragma unroll
        for (int t = 0; t < 8; ++t) {
#pragma unroll
            for (int g4 = 0; g4 < 4; ++g4) {
                const int o = 32 * t + 8 * g4;
                const v2u gw = gwv[4 * t + g4]; const f32x4 gv = *(const LAS f32x4*)(gg + o);
                const float y0 = (acc[t][4 * g4] - mean) * rstd * gv.x * bf_lo(gw.x), y1 = (acc[t][4 * g4 + 1] - mean) * rstd * gv.y * bf_hi(gw.x);
                const float y2 = (acc[t][4 * g4 + 2] - mean) * rstd * gv.z * bf_lo(gw.y), y3 = (acc[t][4 * g4 + 3] - mean) * rstd * gv.w * bf_hi(gw.y);
                v2u ov; ov.x = pk2(y0, y1); ov.y = pk2(y2, y3); *(GAS v2u*)(ao + o) = ov;
            }
            if (t & 1) __builtin_amdgcn_sched_barrier(0); }
    }
#undef R3_GRAN
#undef R3_STEP
#undef R3_ISSUE_Q
    asm volatile("s_waitcnt vmcnt(0) lgkmcnt(0)" ::: "memory"); __syncthreads();
}

__device__ constexpr float W32C[16] = {1.000000000f, 0.980785280f, 0.923879533f, 0.831469612f, 0.707106781f, 0.555570233f, 0.382683432f, 0.195090322f, 0.000000000f, -0.195090322f, -0.382683432f, -0.555570233f, -0.707106781f, -0.831469612f, -0.923879533f, -0.980785280f};
__device__ constexpr float W32S[16] = {0.000000000f, 0.195090322f, 0.382683432f, 0.555570233f, 0.707106781f, 0.831469612f, 0.923879533f, 0.980785280f, 1.000000000f, 0.980785280f, 0.923879533f, 0.831469612f, 0.707106781f, 0.555570233f, 0.382683432f, 0.195090322f};
__host__ __device__ constexpr int brev5(int p) { return ((p & 1) << 4) | ((p & 2) << 2) | (p & 4) | ((p & 8) >> 2) | ((p & 16) >> 4); }
__device__ __forceinline__ void ffta_phase(Frame& F) {
    const bf16* Yt = (const bf16*)(F.ws + WS_YT); bf16* Gm = (bf16*)(F.ws + WS_G);
    int tid = F.tid; asm volatile("" : "+v"(tid));
#pragma unroll 1
    for (int idx = F.bid * (NWAVES * 64) + tid; idx < D_ * 256; idx += F.G * (NWAVES * 64)) {
        const int col = idx >> 8, s2 = idx & 255;
        const GAS bf16* src = (const GAS bf16*)(Yt + (size_t)col * 16384 + s2);
        float xr[32], xi[32];
#pragma unroll
        for (int s1 = 0; s1 < 32; ++s1) { xr[s1] = __builtin_bit_cast(float, (unsigned)src[256 * s1] << 16); xi[s1] = -__builtin_bit_cast(float, (unsigned)src[8192 + 256 * s1] << 16); }
#pragma unroll
        for (int len = 32; len >= 2; len >>= 1) {
            const int half = len >> 1, step = 32 / len;
#pragma unroll
            for (int i = 0; i < 32; i += len)
#pragma unroll
                for (int j = 0; j < half; ++j) {
                    const float ar = xr[i + j], ai = xi[i + j], br = xr[i + j + half], bi = xi[i + j + half];
                    xr[i + j] = ar + br; xi[i + j] = ai + bi;
                    const float dr = ar - br, di = ai - bi, c = W32C[j * step], sn = W32S[j * step];
                    xr[i + j + half] = dr * c + di * sn; xi[i + j + half] = di * c - dr * sn;
                }
        }
        GAS bf16* dst = (GAS bf16*)(Gm + (size_t)col * 512 + s2);
#pragma unroll
        for (int p = 0; p < 32; ++p) {
            const int k = brev5(p);
            const float rev = (float)((s2 * k) & 8191) * (1.f / 8192.f); const float c = cos_rev(rev), sn = sin_rev(rev);
            const float gr = xr[p] * c + xi[p] * sn, gi = xi[p] * c - xr[p] * sn;
            dst[(size_t)k * (D_ * 512)] = pg8::f2bf1(gr); dst[(size_t)k * (D_ * 512) + 256] = pg8::f2bf1(gi);
        }
    }
}

constexpr int NPH = 18;
__global__ void __launch_bounds__(NWAVES * 64, 2) enc_fwd(Args args) {
    extern __shared__ __attribute__((aligned(16))) unsigned char lds[];
    Frame F;
    F.lds = (LAS unsigned char*)lds; F.MISC = (volatile LAS unsigned*)(F.lds + MISC_OFF);
    F.tid = threadIdx.x; F.wave = __builtin_amdgcn_readfirstlane(F.tid >> 6); F.G = gridDim.x; F.bid = blockIdx.x;
    F.ws = args.ws; F.ctl = (unsigned*)(args.ws + WS_CTL);
    F.x = args.in[0]; F.c = args.in[1]; F.ada_w = args.in[2]; F.ada_b = args.in[3]; F.norm_g = args.in[4]; F.w_in = args.in[5]; F.w_out = args.in[6]; F.gn_g = args.in[7];
    F.decf = args.in[8]; F.decb = args.in[9]; F.fno_w = args.in[10]; F.fno_b = args.in[11]; F.w1 = args.in[12]; F.w2 = args.in[13]; F.out = args.out;
    for (int u = F.tid; u < (LDS_BYTES - LDSCTL_OFF) / 4; u += NWAVES * 64) ((LAS unsigned*)(F.lds + LDSCTL_OFF))[u] = 0u;
    __syncthreads();
    const int lo = args.ph_lo, hi = args.ph_hi;
    XcdBarrier bar; bar.bar = (unsigned*)(F.ctl + CW_BAR) + args.li * XCD_BAR_WORDS; bar.x = 0; bar.st = nullptr;
    if (hi - lo > 1) bar = xcd_barrier_post((unsigned*)(F.ctl + CW_BAR) + args.li * XCD_BAR_WORDS, F.MISC + 8);
#ifndef PHMASK
#define PHMASK 0x3ffff
#endif
#define IN(k) (((PHMASK >> (k)) & 1) && lo <= (k) && (k) < hi)
#define SEAM(k) do { if (IN(k) && IN((k) + 1)) xcd_barrier(bar); } while (0)
    unsigned char* ws = args.ws;
    const float* MOD = (const float*)(ws + WS_MOD);
    bf16* XN = (bf16*)(ws + WS_XN); bf16* XA = (bf16*)(ws + WS_XA); bf16* Y = (bf16*)(ws + WS_Y); bf16* HB = (bf16*)(ws + WS_HB);
    const float* NG = F.norm_g;
#define MODV(l, i) (MOD + (size_t)(l) * NMOD + (i) * D_)
#define NGV(l, i) (NG + ((l) * 4 + (i)) * D_)

    if (IN(0)) { p0_prologue(F, CW_Q); } SEAM(0);
    if (IN(1)) { norm_phase<0, false>(F, F.x, nullptr, nullptr, XN, nullptr, nullptr, NGV(0, 0), MODV(0, 1), MODV(0, 0)); } SEAM(1);
    if (IN(2)) {
        pg8::Gemm g{XN, (const bf16*)(ws + WS_WIN), D_, D_, D_, 0, 0}; pg8::StaticOrder S; S.init(S_, WIN, F.G, F.bid);
        pg8::EpiWin E{(bf16*)(ws + WS_Q0), (bf16*)(ws + WS_K0), (bf16*)(ws + WS_KFT), (bf16*)(ws + WS_KBT), (bf16*)(ws + WS_VT), (bf16*)(ws + WS_SG),
                      F.decf, F.decb, S_, F.lds + 131072};
        pg8::gemm_phase<pg8::EpiWin, pg8::StaticOrder, PG8_ALIGN, PG8_SP2>(F.lds + RING_OFF, g, S, E);
    } SEAM(2);
    if (IN(3)) { rs_phase(F); } SEAM(3);
    if (IN(4)) { r3_phase(F); conv_phase(F, F.w_out, (bf16*)(ws + WS_WOUT), VW, D_, PI_TWOUT, CW_Q + 64); } SEAM(4);
    if (IN(5)) {
        pg8::Gemm g{(const bf16*)(ws + WS_A2), (const bf16*)(ws + WS_WOUT), VW, VW, VW, 0, 0}; pg8::StaticOrder S; S.init(S_, D_, F.G, F.bid);
        pg8::EpiBf16<0> E{Y, D_, nullptr};
        pg8::gemm_phase<pg8::EpiBf16<0>, pg8::StaticOrder, PG8_ALIGN, PG8_SP2>(F.lds + RING_OFF, g, S, E);
    } SEAM(5);
    if (IN(6)) { norm_phase<1, false>(F, F.x, Y, XA, XN, MODV(0, 2), NGV(0, 1), NGV(0, 2), MODV(0, 4), MODV(0, 3)); conv_phase(F, F.w1, (bf16*)(ws + WS_W1), D_, DFF, PI_TW1, CW_Q + 128); } SEAM(6);
    if (IN(7)) {
        pg8::Gemm g{XN, (const bf16*)(ws + WS_W1), D_, D_, D_, 0, 0}; pg8::StaticOrder S; S.init(S_, DFF, F.G, F.bid);
        pg8::EpiBf16<1> E{HB, DFF, nullptr};
        pg8::gemm_phase<pg8::EpiBf16<1>, pg8::StaticOrder, PG8_ALIGN, PG8_SP2>(F.lds + RING_OFF, g, S, E);
        conv_phase(F, F.w2, (bf16*)(ws + WS_W2), DFF, D_, PI_TW2, CW_Q + 256);
    } SEAM(7);
    if (IN(8)) {
        pg8::Gemm g{HB, (const bf16*)(ws + WS_W2), DFF, DFF, DFF, 0, 0}; pg8::StaticOrder S; S.init(S_, D_, F.G, F.bid);
        pg8::EpiBf16<0> E{Y, D_, nullptr};
        pg8::gemm_phase<pg8::EpiBf16<0>, pg8::StaticOrder, PG8_ALIGN, PG8_SP2>(F.lds + RING_OFF, g, S, E);
    } SEAM(8);
    if (IN(9)) { norm_phase<1, true>(F, XA, Y, XA, XN, MODV(0, 5), NGV(0, 3), NGV(1, 0), MODV(1, 1), MODV(1, 0)); } SEAM(9);
    if (IN(10)) {
        pg8::Gemm g{(const bf16*)(ws + WS_T512), XN, 512, D_, 512, 0, 512}; pg8::BatchOrder S; S.init(1024, S_, 8, F.G, F.bid);
        pg8::EpiFft1 E{(bf16*)(ws + WS_YT)};
        pg8::gemm_phase<pg8::EpiFft1, pg8::BatchOrder, PG8_ALIGN, PG8_SP2>(F.lds + RING_OFF, g, S, E);
    } SEAM(10);
    if (IN(11)) { ffta_phase(F); } SEAM(11);
    if (IN(12)) {
        pg8::Gemm g{(const bf16*)(ws + WS_AB), (const bf16*)(ws + WS_G), 512, 512, 512, 0, (size_t)D_ * 512}; pg8::BatchOrder S; S.init(256, D_, 32, F.G, F.bid);
        pg8::EpiMixB E{(bf16*)(ws + WS_MIX)};
        pg8::gemm_phase<pg8::EpiMixB, pg8::BatchOrder, PG8_ALIGN, PG8_SP2>(F.lds + RING_OFF, g, S, E);
        conv_phase(F, F.fno_w, (bf16*)(ws + WS_WF), D_, D_, PI_TWF, CW_Q + 384);
    } SEAM(12);
    if (IN(13)) {
        pg8::Gemm g{(const bf16*)(ws + WS_MIX), (const bf16*)(ws + WS_WF), D_, D_, D_, 0, 0}; pg8::StaticOrder S; S.init(S_, D_, F.G, F.bid);
        pg8::EpiBf16<0> E{Y, D_, F.fno_b};
        pg8::gemm_phase<pg8::EpiBf16<0>, pg8::StaticOrder, PG8_ALIGN, PG8_SP2>(F.lds + RING_OFF, g, S, E);
    } SEAM(13);
    if (IN(14)) { norm_phase<1, true>(F, XA, Y, XA, XN, MODV(1, 2), NGV(1, 1), NGV(1, 2), MODV(1, 4), MODV(1, 3)); conv_phase(F, F.w1 + (size_t)D_ * DFF, (bf16*)(ws + WS_W1) + (size_t)D_ * DFF, D_, DFF, PI_TW1, CW_Q + 192); } SEAM(14);
    if (IN(15)) {
        pg8::Gemm g{XN, (const bf16*)(ws + WS_W1) + (size_t)D_ * DFF, D_, D_, D_, 0, 0}; pg8::StaticOrder S; S.init(S_, DFF, F.G, F.bid);
        pg8::EpiBf16<1> E{HB, DFF, nullptr};
        pg8::gemm_phase<pg8::EpiBf16<1>, pg8::StaticOrder, PG8_ALIGN, PG8_SP2>(F.lds + RING_OFF, g, S, E);
        conv_phase(F, F.w2 + (size_t)D_ * DFF, (bf16*)(ws + WS_W2) + (size_t)D_ * DFF, DFF, D_, PI_TW2, CW_Q + 320);
    } SEAM(15);
    if (IN(16)) {
        pg8::Gemm g{HB, (const bf16*)(ws + WS_W2) + (size_t)D_ * DFF, DFF, DFF, DFF, 0, 0}; pg8::StaticOrder S; S.init(S_, D_, F.G, F.bid);
        pg8::EpiBf16<0> E{Y, D_, nullptr};
        pg8::gemm_phase<pg8::EpiBf16<0>, pg8::StaticOrder, PG8_ALIGN, PG8_SP2>(F.lds + RING_OFF, g, S, E);
    } SEAM(16);
    if (IN(17)) { norm_phase<2, true>(F, XA, Y, F.out, nullptr, MODV(1, 5), NGV(1, 3), nullptr, nullptr, nullptr); }
#undef IN
#undef SEAM
}

extern "C" void kernel_launch(void* const* d_in, const int* in_sizes, int n_in, void* d_out, int out_size, void* d_ws, size_t ws_size, hipStream_t stream) {
    static int grid = 0;
    if (grid == 0) {
        if (n_in != 14 || out_size != S_ * D_ || ws_size < WS_END) { fprintf(stderr, "kernel_launch: unexpected problem (n_in %d, out %d, ws %zu < %zu)\n", n_in, out_size, ws_size, (size_t)WS_END); grid = -1; return; }
        int dev = 0, cus = 0, per_cu = 0;
        if (hipGetDevice(&dev) != hipSuccess || hipDeviceGetAttribute(&cus, hipDeviceAttributeMultiprocessorCount, dev) != hipSuccess) { grid = -1; return; }
        if (hipFuncSetAttribute((const void*)enc_fwd, hipFuncAttributeMaxDynamicSharedMemorySize, LDS_BYTES) != hipSuccess) { fprintf(stderr, "kernel_launch: hipFuncSetAttribute failed\n"); grid = -1; return; }
        if (hipOccupancyMaxActiveBlocksPerMultiprocessor(&per_cu, (const void*)enc_fwd, NWAVES * 64, LDS_BYTES) != hipSuccess || per_cu < 1) fprintf(stderr, "kernel_launch: occupancy query reports %d\n", per_cu);
        (void)hipGetLastError();
        grid = cus;
    }
    if (grid < 0) return;
    (void)hipMemsetAsync((char*)d_ws + WS_CTL, 0, CTL_ZERO_BYTES, stream);
    Args a{};
    for (int i = 0; i < 14; ++i) a.in[i] = (const float*)d_in[i];
    a.out = (float*)d_out; a.ws = (unsigned char*)d_ws; a.pad = 0;
#if MK_SINGLE
    a.ph_lo = 0; a.ph_hi = NPH; a.li = 0;
    hipLaunchKernelGGL(enc_fwd, dim3(grid), dim3(NWAVES * 64), LDS_BYTES, stream, a);
#else
    for (int p = 0; p < NPH; ++p) { a.ph_lo = p; a.ph_hi = p + 1; a.li = p; hipLaunchKernelGGL(enc_fwd, dim3(grid), dim3(NWAVES * 64), LDS_BYTES, stream, a); }
#endif
}
```

```cpp
#include <hip/hip_runtime.h>
#include <cstdio>
#include <cstdint>

#ifndef MK_SINGLE
#define MK_SINGLE 1
#endif

namespace pg8 {
#define PG8_LAS __attribute__((address_space(3)))
typedef unsigned short bf16_t;
typedef short bf16x8 __attribute__((ext_vector_type(8)));
typedef float f32x4 __attribute__((ext_vector_type(4)));
typedef unsigned u32x4 __attribute__((ext_vector_type(4)));
constexpr int BM = 256, BK = 64, HALF = 128, HTB = HALF * BK * 2  , STAGE_BYTES = 8 * HTB, NXCD = 8, WGM = 8;

__host__ __device__ __forceinline__ int lds_byte(int r, int c) { const int st = (r >> 4) * 2 + (c >> 5), rr = r & 15, cc = c & 31, ob = rr * 64 + cc * 2; return st * 1024 + (ob ^ (((ob >> 9) & 1) << 5)); }
__host__ __device__ __forceinline__ void stage_rc(int b, int& R, int& C) { const int st = b / 1024, sb = b % 1024, swz = sb ^ (((sb >> 9) & 1) << 5); R = (st >> 1) * 16 + swz / 64; C = (st & 1) * 32 + (swz % 64) / 2; }
__host__ __device__ __forceinline__ int perm32(int rho) { const int n = rho >> 4, i = rho & 15; return 8 * (i >> 2) + 4 * n + (i & 3); }

struct Unit { int pm, pn, z; };
struct Gemm { const bf16_t* A; const bf16_t* Bt; int lda, ldb, K; size_t zA, zB; };

struct StaticOrder {
    int nM, nN, nwg, G, c;
    __host__ __device__ void init(int M, int N, int G_, int c_) { nM = M / BM; nN = N / BM; nwg = nM * nN; G = G_; c = c_; }
    __host__ __device__ bool next(int i, Unit& u) const {
        const long L = (long)i * G + c; if (L >= nwg) return false;
        int wgid = (int)L; { const int q = nwg / NXCD, r = nwg % NXCD, xcd = wgid % NXCD, off = wgid / NXCD; wgid = (xcd < r ? xcd * (q + 1) : r * (q + 1) + (xcd - r) * q) + off; }
        const int nig = WGM * nN, gid = wgid / nig, fm = gid * WGM, gsz = (nM - fm) < WGM ? (nM - fm) : WGM;
        u.pm = fm + ((wgid % nig) % gsz); u.pn = (wgid % nig) / gsz; u.z = 0; return true;
    }
    __device__ __forceinline__ void a_ready(const Unit&) const {}
    __device__ __forceinline__ void done(const Unit&) const {}
};
struct BatchOrder {
    int nM, nN, nz, nwg, G, c;
    __host__ __device__ void init(int M, int N, int nz_, int G_, int c_) { nM = M / BM; nN = N / BM; nz = nz_; nwg = nM * nN * nz; G = G_; c = c_; }
    __host__ __device__ bool next(int i, Unit& u) const {
        const long L = (long)i * G + c; if (L >= nwg) return false;
        const int per = nM * nN, l = (int)L; u.z = l / per; const int r = l % per; u.pn = r / nM; u.pm = r % nM; return true;
    }
    __device__ __forceinline__ void a_ready(const Unit&) const {}
    __device__ __forceinline__ void done(const Unit&) const {}
};

__device__ __forceinline__ unsigned cvt_pk_bf16(float lo, float hi) { unsigned r; asm volatile("v_cvt_pk_bf16_f32 %0, %1, %2" : "=v"(r) : "v"(lo), "v"(hi)); return r; }
__device__ __forceinline__ u32x4 pack8(const f32x4 v0, const f32x4 v1) { u32x4 w; w.x = cvt_pk_bf16(v0[0], v0[1]); w.y = cvt_pk_bf16(v0[2], v0[3]); w.z = cvt_pk_bf16(v1[0], v1[1]); w.w = cvt_pk_bf16(v1[2], v1[3]); return w; }
__device__ __forceinline__ bf16_t f2bf1(float f) { return (bf16_t)(cvt_pk_bf16(f, f) & 0xffffu); }

template <int ACT> struct EpiBf16 {
    static constexpr bool PERM = true, AFTER_DRAIN = false;
    bf16_t* O; int ldc; const float* bias;
    __device__ __forceinline__ void operator()(const f32x4 (&acc)[2][2][4][2], const Unit& u, int wr, int wc, int fr, int fq) const {
        const int row0 = u.pm * BM + wr * 64 + fr; const int col0 = u.pn * BM + wc * 32 + 8 * fq;
        f32x4 bv[2][2];
#pragma unroll
        for (int bj = 0; bj < 2; ++bj)
#pragma unroll
            for (int n = 0; n < 2; ++n) bv[bj][n] = bias ? *(const f32x4*)(bias + col0 + bj * HALF + 4 * n) : (f32x4){0.f, 0.f, 0.f, 0.f};
#pragma unroll
        for (int ai = 0; ai < 2; ++ai)
#pragma unroll
            for (int m = 0; m < 4; ++m) { bf16_t* rowp = O + (size_t)(row0 + ai * HALF + m * 16) * ldc + col0;
#pragma unroll
                for (int bj = 0; bj < 2; ++bj) { f32x4 v0 = acc[ai][bj][m][0] + bv[bj][0], v1 = acc[ai][bj][m][1] + bv[bj][1];
                    if (ACT == 1) {
#pragma unroll
                        for (int e = 0; e < 4; ++e) { const float a = fmaxf(v0[e], 0.f), b = fmaxf(v1[e], 0.f); v0[e] = a * a; v1[e] = b * b; } }
                    *(u32x4*)(rowp + bj * HALF) = pack8(v0, v1); } }
    }
};
struct EpiFft1 {
    static constexpr bool PERM = true, AFTER_DRAIN = false;
    bf16_t* O;
    __device__ __forceinline__ void operator()(const f32x4 (&acc)[2][2][4][2], const Unit& u, int wr, int wc, int fr, int fq) const {
        const int r0 = (u.pm & 1) * BM + wr * 64 + fr, cs = u.pm >> 1; const int col0 = u.pn * BM + wc * 32 + 8 * fq;
#pragma unroll
        for (int ai = 0; ai < 2; ++ai)
#pragma unroll
            for (int m = 0; m < 4; ++m) { bf16_t* rowp = O + ((size_t)(u.z * 512 + r0 + ai * HALF + m * 16) * 2 + cs) * 8192 + col0;
#pragma unroll
                for (int bj = 0; bj < 2; ++bj) *(u32x4*)(rowp + bj * HALF) = pack8(acc[ai][bj][m][0], acc[ai][bj][m][1]); }
    }
};
struct EpiMixB {
    static constexpr bool PERM = true, AFTER_DRAIN = false;
    bf16_t* O;
    __device__ __forceinline__ void operator()(const f32x4 (&acc)[2][2][4][2], const Unit& u, int wr, int wc, int fr, int fq) const {
        const int r0 = wr * 64 + fr; const int col0 = u.pn * BM + wc * 32 + 8 * fq;
#pragma unroll
        for (int ai = 0; ai < 2; ++ai)
#pragma unroll
            for (int m = 0; m < 4; ++m) { bf16_t* rowp = O + (size_t)(32 * (r0 + ai * HALF + m * 16) + u.z) * 4096 + col0;
#pragma unroll
                for (int bj = 0; bj < 2; ++bj) *(u32x4*)(rowp + bj * HALF) = pack8(acc[ai][bj][m][0], acc[ai][bj][m][1]); }
    }
};
constexpr int RC = 256;
__device__ __forceinline__ float lg2_sigmoid(float d) { return -log1pf(__expf(-d)) * 1.44269504089f; }
__device__ __forceinline__ size_t off_qt(int h, int t, int dk) { return ((((size_t)(h * 256 + (t >> 5)) * 16 + (dk >> 4)) * 2 + ((dk >> 3) & 1)) * 32 + (t & 31)) * 8 + (dk & 7); }
__device__ __forceinline__ void tr_store16(PG8_LAS unsigned char* sw, int fr, int fq, const f32x4 (&v)[2][2], float scale, bf16_t* tile0, int ndim) {
    PG8_LAS bf16_t* wp = (PG8_LAS bf16_t*)(sw + ((fr >> 2) & 1) * 16 + (4 * (fr >> 3) + (fr & 3)) * 2);
#pragma unroll
    for (int bj = 0; bj < 2; ++bj)
#pragma unroll
        for (int n = 0; n < 2; ++n)
#pragma unroll
            for (int e = 0; e < 4; ++e) wp[(bj * 32 + fq * 8 + n * 4 + e) * 16] = f2bf1(v[bj][n][e] * scale);
    asm volatile("" ::: "memory");
    const int lane = fq * 16 + fr;
#pragma unroll
    for (int k = 0; k < 2; ++k) { const int q = lane + 64 * k, col = q >> 1, hq = q & 1;
        const u32x4 val = *(const PG8_LAS u32x4*)(sw + q * 16);
        *(u32x4*)(tile0 + ((size_t)hq * ndim + (col >> 5) * 128 + (col & 31)) * 8) = val; }
    asm volatile("" ::: "memory");
}
struct EpiWin {
    static constexpr bool PERM = true, AFTER_DRAIN = false;
    bf16_t *Q0, *K0, *KFT, *KBT, *VT, *SG; const float* decf; const float* decb; int S; PG8_LAS unsigned char* scr;
    __device__ __forceinline__ void operator()(const f32x4 (&acc)[2][2][4][2], const Unit& u, int wr, int wc, int fr, int fq) const {
        const int pn = u.pn; const int rowb = u.pm * BM + wr * 64 + fr; const int cj = wc * 32 + fq * 8;
        PG8_LAS unsigned char* sw = scr + (wr * 4 + wc) * 2048;
        if (pn < 32) {
            const bool isk = pn >= 16; const int h = pn & 15;
            const float lf2 = lg2_sigmoid(decf[h]), lb2 = lg2_sigmoid(decb[h]);
            float inv[8];
#pragma unroll
            for (int e = 0; e < 8; ++e) inv[e] = __builtin_amdgcn_exp2f(-(float)(cj + e) * (13.287712379549449f / 128.f));
#pragma unroll
            for (int ai = 0; ai < 2; ++ai)
#pragma unroll
                for (int m = 0; m < 4; ++m) {
                    const int row = rowb + ai * HALF + m * 16;
                    f32x4 c0, c1, s0, s1;
#pragma unroll
                    for (int e = 0; e < 4; ++e) {
                        const float r0 = __builtin_amdgcn_fractf(((float)row * inv[e]) * 0.15915494309189535f), r1 = __builtin_amdgcn_fractf(((float)row * inv[4 + e]) * 0.15915494309189535f);
                        c0[e] = __builtin_amdgcn_cosf(r0); s0[e] = __builtin_amdgcn_sinf(r0); c1[e] = __builtin_amdgcn_cosf(r1); s1[e] = __builtin_amdgcn_sinf(r1); }
                    const f32x4 x1a = acc[ai][0][m][0], x1b = acc[ai][0][m][1], x2a = acc[ai][1][m][0], x2b = acc[ai][1][m][1];
                    f32x4 o1a = x1a * c0 - x2a * s0, o1b = x1b * c1 - x2b * s1, o2a = x1a * s0 + x2a * c0, o2b = x1b * s1 + x2b * c1;
                    const int jj = row & (RC - 1);
                    const size_t o1 = off_qt(h, row, cj), o2 = off_qt(h, row, 128 + cj);
                    if (!isk) {
                        *(u32x4*)(Q0 + o1) = pack8(o1a, o1b); *(u32x4*)(Q0 + o2) = pack8(o2a, o2b);
                    } else {
                        o1a = o1a * 0.0625f; o1b = o1b * 0.0625f; o2a = o2a * 0.0625f; o2b = o2b * 0.0625f;
                        *(u32x4*)(K0 + o1) = pack8(o1a, o1b); *(u32x4*)(K0 + o2) = pack8(o2a, o2b);
                        const float f = __builtin_amdgcn_exp2f((float)(RC - 1 - jj) * lf2), b = __builtin_amdgcn_exp2f((float)jj * lb2);
                        const int row0 = row - fr;
                        const size_t tb = ((((size_t)(h * 256 + (row0 >> 5)) * 2 + ((row0 >> 4) & 1)) * 2) * 256 + wc * 32) * 8;
                        const f32x4 ov[2][2] = {{o1a, o1b}, {o2a, o2b}};
                        tr_store16(sw, fr, fq, ov, f, KFT + tb, 256);
                        tr_store16(sw, fr, fq, ov, b, KBT + tb, 256);
                    }
                }
        } else if (pn < 64) {
            const int h = (pn - 32) >> 1, dv0 = ((pn - 32) & 1) * 256 + wc * 32;
#pragma unroll
            for (int ai = 0; ai < 2; ++ai)
#pragma unroll
                for (int m = 0; m < 4; ++m) { const int row0 = rowb - fr + ai * HALF + m * 16;
                    const f32x4 ov[2][2] = {{acc[ai][0][m][0], acc[ai][0][m][1]}, {acc[ai][1][m][0], acc[ai][1][m][1]}};
                    tr_store16(sw, fr, fq, ov, 1.0f, VT + ((((size_t)(h * 256 + (row0 >> 5)) * 2 + ((row0 >> 4) & 1)) * 2) * 512 + dv0) * 8, 512); }
        } else {
            const int cb = (pn - 64) * 256 + cj;
#pragma unroll
            for (int ai = 0; ai < 2; ++ai)
#pragma unroll
                for (int m = 0; m < 4; ++m) { bf16_t* rowp = SG + (size_t)(rowb + ai * HALF + m * 16) * 8192 + cb;
#pragma unroll
                    for (int bj = 0; bj < 2; ++bj) { f32x4 v0 = acc[ai][bj][m][0], v1 = acc[ai][bj][m][1];
#pragma unroll
                        for (int e = 0; e < 4; ++e) { v0[e] = v0[e] * __builtin_amdgcn_rcpf(1.f + __expf(-v0[e])); v1[e] = v1[e] * __builtin_amdgcn_rcpf(1.f + __expf(-v1[e])); }
                        *(u32x4*)(rowp + bj * HALF) = pack8(v0, v1); } }
        }
    }
};

template <class Epi, class Sched, bool ALIGN_EPI = false, bool SP2 = false, bool KFIX = false>
__device__ __forceinline__ void gemm_phase(PG8_LAS unsigned char* lds, const Gemm g, const Sched& S, const Epi& E) {
    const int tid = threadIdx.x, wid = __builtin_amdgcn_readfirstlane(tid >> 6), lane = tid & 63, wr = wid >> 2, wc = wid & 3, fr = lane & 15, fq = lane >> 4;
    const int K = g.K, nt = K / BK;
    unsigned voffA[2], voffB[2];
#pragma unroll
    for (int i = 0; i < 2; ++i) { int R, C; stage_rc(tid * 16 + i * 8192, R, C); const int Rb = Epi::PERM ? ((R & ~31) + perm32(R & 31)) : R;
        voffA[i] = (unsigned)(R * g.lda + C) * 2u; voffB[i] = (unsigned)(Rb * g.ldb + C) * 2u; }
    const size_t kstep = KFIX ? (size_t)0 : (size_t)(BK * 2);
    const size_t hstepA = (size_t)HALF * g.lda * 2, hstepB = (size_t)HALF * g.ldb * 2;
    const size_t tstepA = 2 * hstepA, tstepB = 2 * hstepB;
    const unsigned ldsw = (unsigned)wid * 1024u;
    const int aoff = lds_byte(wr * 64 + fr, fq * 8), boff = lds_byte(wc * 32 + fr, fq * 8);
#define PG8_SA(b, h) (((b) * 2 + (h)) * HTB)
#define PG8_SB(b, h) ((4 + (b) * 2 + (h)) * HTB)
#define PG8_STAGE(bufoff, gbase, voff) do { _Pragma("unroll") for (int _i = 0; _i < 2; ++_i) \
        __builtin_amdgcn_global_load_lds((const unsigned*)((const char*)(gbase) + (voff)[_i]), (PG8_LAS unsigned*)(lds + (bufoff) + ldsw + _i * 8192), 16, 0, 0); } while (0)
#define PG8_LDA(dst, b, h) do { _Pragma("unroll") for (int m = 0; m < 4; ++m) _Pragma("unroll") for (int k = 0; k < 2; ++k) dst[m][k] = *(const PG8_LAS bf16x8*)(lds + PG8_SA(b, h) + aoff + m * 2048 + k * 1024); } while (0)
#define PG8_LDB(dst, b, h) do { _Pragma("unroll") for (int n = 0; n < 2; ++n) _Pragma("unroll") for (int k = 0; k < 2; ++k) dst[n][k] = *(const PG8_LAS bf16x8*)(lds + PG8_SB(b, h) + boff + n * 2048 + k * 1024); } while (0)
#define PG8_MMA(ai, bj, At, Bt) do { __builtin_amdgcn_s_setprio(1); _Pragma("unroll") for (int m = 0; m < 4; ++m) _Pragma("unroll") for (int n = 0; n < 2; ++n) _Pragma("unroll") for (int k = 0; k < 2; ++k) \
        acc[ai][bj][m][n] = __builtin_amdgcn_mfma_f32_16x16x32_bf16(Bt[n][k], At[m][k], acc[ai][bj][m][n], 0, 0, 0); __builtin_amdgcn_s_setprio(0); } while (0)
#define PG8_WAIT_V(n) asm volatile("s_waitcnt vmcnt(" #n ")" ::: "memory")
#define PG8_WAIT_L(n) asm volatile("s_waitcnt lgkmcnt(" #n ")" ::: "memory")
#define PG8_BAR __builtin_amdgcn_s_barrier()
#define PG8_SCHED __builtin_amdgcn_sched_barrier(0)
    Unit cur, nxt; int ui = 0;
    if (!S.next(0, cur)) return;
    f32x4 acc[2][2][4][2];
#pragma unroll
    for (int a = 0; a < 2; ++a)
#pragma unroll
        for (int b = 0; b < 2; ++b)
#pragma unroll
            for (int m = 0; m < 4; ++m)
#pragma unroll
                for (int n = 0; n < 2; ++n) acc[a][b][m][n] = (f32x4){0.f, 0.f, 0.f, 0.f};
    bf16x8 At[4][2], B0[2][2], B1[2][2];
    const char* cA = (const char*)(g.A + (size_t)cur.z * g.zA) + (size_t)cur.pm * tstepA; const char* cB = (const char*)(g.Bt + (size_t)cur.z * g.zB) + (size_t)cur.pn * tstepB;
    S.a_ready(cur);
    if constexpr (SP2) {
        PG8_STAGE(PG8_SB(0, 0), cB, voffB); PG8_STAGE(PG8_SB(0, 1), cB + hstepB, voffB); PG8_STAGE(PG8_SA(0, 0), cA, voffA); PG8_STAGE(PG8_SA(0, 1), cA + hstepA, voffA);
        if (wr == 1) PG8_BAR;
        PG8_WAIT_V(2); PG8_BAR;
        PG8_STAGE(PG8_SB(1, 0), cB + kstep, voffB); PG8_STAGE(PG8_SA(1, 0), cA + kstep, voffA); PG8_STAGE(PG8_SB(1, 1), cB + hstepB + kstep, voffB);
        PG8_WAIT_V(6); PG8_BAR;
    } else {
        PG8_STAGE(PG8_SB(0, 0), cB, voffB); PG8_STAGE(PG8_SA(0, 0), cA, voffA); PG8_STAGE(PG8_SB(0, 1), cB + hstepB, voffB); PG8_STAGE(PG8_SA(0, 1), cA + hstepA, voffA);
        if (wr == 1) PG8_BAR;
        PG8_WAIT_V(4); PG8_BAR;
        PG8_STAGE(PG8_SB(1, 0), cB + kstep, voffB); PG8_STAGE(PG8_SA(1, 0), cA + kstep, voffA); PG8_STAGE(PG8_SB(1, 1), cB + hstepB + kstep, voffB);
        PG8_WAIT_V(6); PG8_BAR;
    }
    for (;;) {
        const bool has_next = S.next(ui + 1, nxt);
        const char* nA = has_next ? (const char*)(g.A + (size_t)nxt.z * g.zA) + (size_t)nxt.pm * tstepA : cA; const char* nB = has_next ? (const char*)(g.Bt + (size_t)nxt.z * g.zB) + (size_t)nxt.pn * tstepB : cB;
        for (int t = 0; t < nt; t += 2) {
            const bool last = (t == nt - 2);
            const char* a1 = cA + (size_t)(t + 1) * kstep;
            const char* a2 = last ? nA : cA + (size_t)(t + 2) * kstep; const char* b2 = last ? nB : cB + (size_t)(t + 2) * kstep;
            const char* a3 = a2 + kstep; const char* b3 = b2 + kstep;
            if (last && has_next) S.a_ready(nxt);
            if constexpr (SP2) {
            PG8_LDB(B0, 0, 0); PG8_LDB(B1, 0, 1); PG8_SCHED; PG8_LDA(At, 0, 0); PG8_STAGE(PG8_SA(1, 1), a1 + hstepA, voffA);
            PG8_WAIT_V(8); PG8_WAIT_L(0); PG8_BAR; PG8_MMA(0, 0, At, B0); PG8_MMA(0, 1, At, B1); PG8_BAR; PG8_SCHED;
            PG8_LDA(At, 0, 1); PG8_STAGE(PG8_SB(0, 0), b2, voffB); PG8_STAGE(PG8_SB(0, 1), b2 + hstepB, voffB); PG8_STAGE(PG8_SA(0, 0), a2, voffA);
            PG8_WAIT_V(8); PG8_WAIT_L(0); PG8_BAR; PG8_MMA(1, 0, At, B0); PG8_MMA(1, 1, At, B1); PG8_BAR; PG8_SCHED;
            PG8_LDB(B0, 1, 0); PG8_LDB(B1, 1, 1); PG8_SCHED; PG8_LDA(At, 1, 0); PG8_STAGE(PG8_SA(0, 1), a2 + hstepA, voffA);
            PG8_WAIT_V(8); PG8_WAIT_L(0); PG8_BAR; PG8_MMA(0, 0, At, B0); PG8_MMA(0, 1, At, B1); PG8_BAR; PG8_SCHED;
            PG8_LDA(At, 1, 1); PG8_STAGE(PG8_SB(1, 0), b3, voffB); PG8_STAGE(PG8_SB(1, 1), b3 + hstepB, voffB); PG8_STAGE(PG8_SA(1, 0), a3, voffA);
            PG8_WAIT_V(8); PG8_WAIT_L(0); PG8_BAR; PG8_MMA(1, 0, At, B0); PG8_MMA(1, 1, At, B1); PG8_BAR; PG8_SCHED;
            } else {
            PG8_LDB(B0, 0, 0); PG8_SCHED; PG8_LDA(At, 0, 0); PG8_STAGE(PG8_SA(1, 1), a1 + hstepA, voffA);
            PG8_WAIT_L(8); PG8_BAR; PG8_WAIT_L(0); PG8_MMA(0, 0, At, B0); PG8_BAR; PG8_SCHED;
            PG8_LDB(B1, 0, 1); PG8_STAGE(PG8_SB(0, 0), b2, voffB);
            PG8_BAR; PG8_WAIT_L(0); PG8_MMA(0, 1, At, B1); PG8_BAR;
            PG8_LDA(At, 0, 1); PG8_STAGE(PG8_SA(0, 0), a2, voffA);
            PG8_BAR; PG8_WAIT_L(0); PG8_MMA(1, 0, At, B0); PG8_BAR; PG8_SCHED;
            PG8_STAGE(PG8_SB(0, 1), b2 + hstepB, voffB);
            PG8_WAIT_V(6); PG8_BAR; PG8_MMA(1, 1, At, B1); PG8_BAR;
            PG8_LDB(B0, 1, 0); PG8_SCHED; PG8_LDA(At, 1, 0); PG8_STAGE(PG8_SA(0, 1), a2 + hstepA, voffA);
            PG8_WAIT_L(8); PG8_BAR; PG8_WAIT_L(0); PG8_MMA(0, 0, At, B0); PG8_BAR; PG8_SCHED;
            PG8_LDB(B1, 1, 1); PG8_STAGE(PG8_SB(1, 0), b3, voffB);
            PG8_BAR; PG8_WAIT_L(0); PG8_MMA(0, 1, At, B1); PG8_BAR;
            PG8_LDA(At, 1, 1); PG8_STAGE(PG8_SA(1, 0), a3, voffA);
            PG8_BAR; PG8_WAIT_L(0); PG8_MMA(1, 0, At, B0); PG8_BAR; PG8_SCHED;
            PG8_STAGE(PG8_SB(1, 1), b3 + hstepB, voffB);
            PG8_WAIT_V(6); PG8_BAR; PG8_MMA(1, 1, At, B1); PG8_BAR;
            }
        }
        if constexpr (ALIGN_EPI) { if (wr == 0) PG8_BAR; }
        E(acc, cur, wr, wc, fr, fq); S.done(cur);
        if (!has_next) break;
#pragma unroll
        for (int a = 0; a < 2; ++a)
#pragma unroll
            for (int b = 0; b < 2; ++b)
#pragma unroll
                for (int m = 0; m < 4; ++m)
#pragma unroll
                    for (int n = 0; n < 2; ++n) acc[a][b][m][n] = (f32x4){0.f, 0.f, 0.f, 0.f};
        cur = nxt; cA = nA; cB = nB; ++ui;
        if constexpr (ALIGN_EPI) { if (wr == 1) PG8_BAR; }
    }
    PG8_WAIT_V(0);
    if constexpr (!ALIGN_EPI) { if (wr == 0) PG8_BAR; }
    PG8_BAR;
#undef PG8_SA
#undef PG8_SB
#undef PG8_STAGE
#undef PG8_LDA
#undef PG8_LDB
#undef PG8_MMA
#undef PG8_WAIT_V
#undef PG8_WAIT_L
#undef PG8_BAR
#undef PG8_SCHED
}
}

#ifndef PG8_SP2
#define PG8_SP2 true
#endif
#ifndef PG8_ALIGN
#define PG8_ALIGN true
#endif

constexpr int NWAVES = 8;
constexpr int S_ = 8192, D_ = 4096, H_ = 16, DK = 256, DV = 512, VW = 8192, WIN = 24576, DFF = 16384, NMOD = 6 * D_;
constexpr int NCH = S_ / pg8::RC;
constexpr float EPS_ = 1e-6f;

constexpr size_t MiB = 1u << 20;
constexpr size_t WS_CTL = 0, CTL_ZERO_BYTES = 1 * MiB;
constexpr size_t WS_MOD = 1 * MiB;
constexpr size_t WS_T512 = 2 * MiB;
constexpr size_t WS_WIN = 16 * MiB;
constexpr size_t WS_WOUT = 208 * MiB;
constexpr size_t WS_WF = 272 * MiB;
constexpr size_t WS_W1 = 304 * MiB;
constexpr size_t WS_W2 = 560 * MiB;
constexpr size_t WS_G = 816 * MiB;
constexpr size_t WS_AB = 944 * MiB;
constexpr size_t WS_XN = 1072 * MiB;
constexpr size_t WS_XA = 1136 * MiB;
constexpr size_t WS_Y = 1264 * MiB;
constexpr size_t WS_Q0 = 1328 * MiB, WS_K0 = 1520 * MiB, WS_KFT = 1584 * MiB, WS_KBT = 1648 * MiB;
constexpr size_t WS_VT = 1712 * MiB;
constexpr size_t WS_SG = 1840 * MiB;
constexpr size_t WS_ST = 1968 * MiB;
constexpr size_t WS_A2 = 2224 * MiB;
constexpr size_t WS_HB = WS_Q0;
constexpr size_t WS_YT = WS_KFT;
constexpr size_t WS_MIX = WS_VT;
constexpr size_t WS_END = 2352 * MiB;
static_assert(WS_ST + (size_t)H_ * NCH * 2 * DV * DK * 2 <= WS_A2, "ST fits");
constexpr int CW_TMO = 0, CW_Q = 64;
constexpr int CW_BAR = 4096;
constexpr int RING_OFF = 0, RING_BYTES = 131072;
constexpr int LDSCTL_OFF = 155648, MISC_OFF = LDSCTL_OFF + 320;
constexpr int LDS_BYTES = 163840;

#define GAS __attribute__((address_space(1)))
#define LAS __attribute__((address_space(3)))
typedef unsigned short bf16;
typedef unsigned v4u __attribute__((ext_vector_type(4)));
typedef unsigned v2u __attribute__((ext_vector_type(2)));
typedef float f32x4 __attribute__((ext_vector_type(4)));
typedef float f32x16 __attribute__((ext_vector_type(16)));
typedef short bf16x8 __attribute__((ext_vector_type(8)));
typedef short bf16x4 __attribute__((ext_vector_type(4)));
typedef GAS unsigned gu32;
#define RLX_AGENT __ATOMIC_RELAXED, __HIP_MEMORY_SCOPE_AGENT
#define LDS_WAIT() asm volatile("s_waitcnt lgkmcnt(0)" ::: "memory")
#define VM_WAIT() asm volatile("s_waitcnt vmcnt(0)" ::: "memory")
__device__ __forceinline__ unsigned pk2(float lo, float hi) { return pg8::cvt_pk_bf16(lo, hi); }
__device__ __forceinline__ float bf_lo(unsigned w) { return __builtin_bit_cast(float, w << 16); }
__device__ __forceinline__ float bf_hi(unsigned w) { return __builtin_bit_cast(float, w & 0xffff0000u); }

#define XB_TMO      128
#define XB_XCNT(j)  (256  + 64 * (j))
#define XB_XSUB(j)  (1280 + 64 * (j))
#define XB_XGEN(j)  (2304 + 64 * (j))
#define XB_TOP      3328
#define XB_TOPGEN   3392
#define XCD_BAR_WORDS 3456
#define XB_SPIN_CAP (1u << 18)
__device__ __forceinline__ unsigned xb_ld(unsigned* p)              { return __hip_atomic_load(p, __ATOMIC_RELAXED, __HIP_MEMORY_SCOPE_AGENT); }
__device__ __forceinline__ unsigned xb_add(unsigned* p, unsigned v) { return __hip_atomic_fetch_add(p, v, __ATOMIC_RELAXED, __HIP_MEMORY_SCOPE_AGENT); }
__device__ __forceinline__ unsigned xb_xcc_id() { return (unsigned)__builtin_amdgcn_s_getreg((3 << 11) | 20) & 0xFu; }
#define XB_SPIN(cond, bar) do { unsigned _sp = 0; while (cond) { __builtin_amdgcn_s_sleep(1); \
    if ((++_sp & 255u) == 0u) { if (xb_ld(&(bar)[XB_TMO])) break; if (_sp > XB_SPIN_CAP) { atomicAdd(&(bar)[XB_TMO], 1u); break; } } } } while (0)
struct XcdBarrier { unsigned* bar; unsigned x; volatile LAS unsigned* st; };
__device__ __forceinline__ XcdBarrier xcd_barrier_post(unsigned* bar, volatile LAS unsigned* st) {
    XcdBarrier b; b.bar = bar; b.x = xb_xcc_id(); b.st = st;
    if (threadIdx.x == 0) (void)xb_add(&bar[XB_XCNT(b.x)], 1u);
    return b;
}
__device__ __forceinline__ void xcd_barrier_complete(unsigned* bar, unsigned x, unsigned& nloc, unsigned& nx) {
    const unsigned G = gridDim.x * gridDim.y * gridDim.z;
    unsigned sum, cnt, mine, sp = 0u;
    for (;;) {
        sum = 0u; cnt = 0u; mine = 0u;
#pragma unroll
        for (unsigned j = 0; j < 16; ++j) { const unsigned c = xb_ld(&bar[XB_XCNT(j)]); sum += c; cnt += (c > 0u) ? 1u : 0u; mine = (j == x) ? c : mine; }
        if (sum == G) break;
        __builtin_amdgcn_s_sleep(1);
        if ((++sp & 255u) == 0u) { if (xb_ld(&bar[XB_TMO])) break; if (sp > XB_SPIN_CAP) { atomicAdd(&bar[XB_TMO], 1u); break; } }
    }
    nloc = mine > 0u ? mine : 1u; nx = cnt > 0u ? cnt : 1u;
}
__device__ __forceinline__ void xcd_barrier(const XcdBarrier& b) {
    asm volatile("s_waitcnt vmcnt(0)" ::: "memory");
    __syncthreads();
    if (threadIdx.x == 0) {
        unsigned* bar = b.bar;
        __builtin_amdgcn_s_waitcnt(0);
        unsigned nloc = b.st[0], nx = b.st[1];
        if (nloc == 0u) { xcd_barrier_complete(bar, b.x, nloc, nx); b.st[0] = nloc; b.st[1] = nx; }
        const unsigned old = xb_add(&bar[XB_XSUB(b.x)], 1u);
        const unsigned gen = old / nloc;
        if (old + 1u == (gen + 1u) * nloc) {
            __builtin_amdgcn_fence(__ATOMIC_RELEASE, "agent");
            asm volatile("s_waitcnt vmcnt(0)" ::: "memory");
            __builtin_amdgcn_fence(__ATOMIC_ACQUIRE, "agent");
            const unsigned og = xb_add(&bar[XB_TOP], 1u);
            const unsigned tg = og / nx;
            if (og + 1u == (tg + 1u) * nx) xb_add(&bar[XB_TOPGEN], 1u);
            else XB_SPIN(xb_ld(&bar[XB_TOPGEN]) == tg, bar);
            asm volatile("" ::: "memory");
            xb_add(&bar[XB_XGEN(b.x)], 1u);
            asm volatile("s_waitcnt vmcnt(0)" ::: "memory");
        } else {
            __builtin_amdgcn_fence(__ATOMIC_ACQUIRE, "agent");
            XB_SPIN(xb_ld(&bar[XB_XGEN(b.x)]) == gen, bar);
            asm volatile("s_waitcnt vmcnt(0)" ::: "memory");
        }
    }
    __syncthreads();
}

struct Args { const float* in[14]; float* out; unsigned char* ws; int ph_lo, ph_hi, li, pad; };
struct Frame {
    LAS unsigned char* lds; volatile LAS unsigned* MISC; unsigned* ctl;
    int tid, wave, G, bid;
    const float *x, *c, *ada_w, *ada_b, *norm_g, *w_in, *w_out, *gn_g, *decf, *decb, *fno_w, *fno_b, *w1, *w2; float* out;
    unsigned char* ws;
};
__device__ __forceinline__ float wave_sum(float v) {
#pragma unroll
    for (int o = 1; o < 64; o <<= 1) v += __shfl_xor(v, o);
    return v;
}

struct TrSub { float v[32]; };
__device__ __forceinline__ void tr_load(TrSub& t, const float* W, int N, int k0, int n0, int lane) {
    const float* p = W + (size_t)(k0 + (lane >> 5)) * N + n0 + (lane & 31);
#pragma unroll
    for (int i = 0; i < 32; ++i) t.v[i] = __builtin_nontemporal_load(p + (size_t)(2 * i) * N);
}
__device__ __forceinline__ void tr_store(const TrSub& t, int K, bf16* WT, int k0, int n0, LAS float* scr, int lane) {
#pragma unroll
    for (int i = 0; i < 32; ++i) scr[(2 * i + (lane >> 5)) * 33 + (lane & 31)] = t.v[i];
    LDS_WAIT(); asm volatile("" ::: "memory");
    const int c = lane & 7;
#pragma unroll
    for (int j = 0; j < 4; ++j) { const int n = (lane >> 3) + 8 * j; const LAS float* s = scr + (8 * c) * 33 + n;
        v4u o; o.x = pk2(s[0 * 33], s[1 * 33]); o.y = pk2(s[2 * 33], s[3 * 33]); o.z = pk2(s[4 * 33], s[5 * 33]); o.w = pk2(s[6 * 33], s[7 * 33]);
        *(GAS v4u*)(WT + (size_t)(n0 + n) * K + k0 + 8 * c) = o; }
    LDS_WAIT(); asm volatile("" ::: "memory");
}
__device__ __forceinline__ void tr_item(const float* W, bf16* WT, int K, int N, int it, LAS float* scr, int wave, int lane) {
    const int nb = N / 256, k0 = (it / nb) * 256, nn = (it % nb) * 256 + wave * 32;
    TrSub ta, tb;
    tr_load(ta, W, N, k0, nn, lane);
    tr_load(tb, W, N, k0 + 64, nn, lane);
    tr_store(ta, K, WT, k0, nn, scr, lane);
    tr_load(ta, W, N, k0 + 128, nn, lane);
    tr_store(tb, K, WT, k0 + 64, nn, scr, lane);
    tr_load(tb, W, N, k0 + 192, nn, lane);
    tr_store(ta, K, WT, k0 + 128, nn, scr, lane);
    tr_store(tb, K, WT, k0 + 192, nn, scr, lane);
}
constexpr int PI_GEMV = 2 * (NMOD / 256);
constexpr int PI_TWIN = (D_ / 256) * (WIN / 256), PI_TWOUT = (VW / 256) * (D_ / 256), PI_TWF = (D_ / 256) * (D_ / 256), PI_TW1 = (D_ / 256) * (DFF / 256), PI_TW2 = (DFF / 256) * (D_ / 256);
constexpr int PI_TR = PI_TWIN;
constexpr int PI_DFT = 4, PI_T512 = 8;
constexpr int PI_TOTAL = PI_GEMV + PI_TR + PI_DFT + PI_T512;
__device__ __forceinline__ float cos_rev(float r) { return __builtin_amdgcn_cosf(r); }
__device__ __forceinline__ float sin_rev(float r) { return __builtin_amdgcn_sinf(r); }

__device__ __forceinline__ void p0_prologue(Frame& F, const int qword) {
    int tid = F.tid; asm volatile("" : "+v"(tid)); const int lane = tid & 63;
    LAS float* sc = (LAS float*)(F.lds);
    LAS float* red = (LAS float*)(F.lds + 16384);
    LAS float* scr = (LAS float*)(F.lds + 32768 + F.wave * 8704);
    for (int i = tid; i < D_; i += NWAVES * 64) { const float v = F.c[i]; sc[i] = v / (1.f + __expf(-v)); }
    __syncthreads();
    for (;;) {
        if (tid == 0) F.MISC[0] = __hip_atomic_fetch_add(F.ctl + qword, 1u, RLX_AGENT);
        __syncthreads();
        int it = (int)F.MISC[0];
        __syncthreads();
        if (it >= PI_TOTAL) break;
        if (it < PI_GEMV) {
            const int l = it / (NMOD / 256), n0 = (it % (NMOD / 256)) * 256;
            const float* W = F.ada_w + (size_t)l * D_ * NMOD + n0 + 4 * lane;
            f32x4 a = {0.f, 0.f, 0.f, 0.f};
            const int kb = F.wave * 512;
            for (int k = 0; k < 512; k += 8) {
                f32x4 w[8];
#pragma unroll
                for (int j = 0; j < 8; ++j) w[j] = __builtin_nontemporal_load((const f32x4*)(W + (size_t)(kb + k + j) * NMOD));
#pragma unroll
                for (int j = 0; j < 8; ++j) a += w[j] * sc[kb + k + j];
            }
            *(LAS f32x4*)(red + F.wave * 256 + 4 * lane) = a;
            __syncthreads();
            if (tid < 256) { float s = 0.f;
#pragma unroll
                for (int w = 0; w < 8; ++w) s += red[w * 256 + tid];
                ((float*)(F.ws + WS_MOD))[(size_t)l * NMOD + n0 + tid] = s + F.ada_b[(size_t)l * NMOD + n0 + tid]; }
            __syncthreads();
            continue;
        }
        it -= PI_GEMV;
        if (it < PI_TR) {
            const float* W; bf16* WT; int K, N;
            W = F.w_in; WT = (bf16*)(F.ws + WS_WIN); K = D_; N = WIN;
            tr_item(W, WT, K, N, it, scr, F.wave, lane);
            continue;
        }
        it -= PI_TR;
        if (it < PI_DFT) {
            bf16* Am = (bf16*)(F.ws + WS_AB);
            for (int i = tid; i < 64 * 512; i += NWAVES * 64) {
                const int r = 64 * it + (i >> 9), k = i & 511;
                const float rev = (float)(((k & 255) * r) & 255) * (1.f / 256.f);
                Am[(size_t)r * 512 + k] = pg8::f2bf1((k >> 8) ? sin_rev(rev) : cos_rev(rev));
            }
            continue;
        }
        it -= PI_DFT;
        {
            bf16* T = (bf16*)(F.ws + WS_T512);
            for (int i = tid; i < 128 * 512; i += NWAVES * 64) {
                const int r = 128 * it + (i >> 9), j = i & 511, cs = r >> 9, jp = r & 511;
                const float rev = (float)((j * jp) & 511) * (1.f / 512.f);
                T[(size_t)r * 512 + j] = pg8::f2bf1(cs ? sin_rev(rev) : cos_rev(rev));
            }
        }
    }
}

__device__ __forceinline__ void conv_phase(Frame& F, const float* W, bf16* WT, int K, int N, int nitems, int qword) {
    int tid = F.tid; asm volatile("" : "+v"(tid)); const int lane = tid & 63;
    LAS float* scr = (LAS float*)(F.lds + 32768 + F.wave * 8704);
    for (;;) {
        if (tid == 0) F.MISC[0] = __hip_atomic_fetch_add(F.ctl + qword, 1u, RLX_AGENT);
        __syncthreads();
        const int it = (int)F.MISC[0];
        __syncthreads();
        if (it >= nitems) break;
        tr_item(W, WT, K, N, it, scr, F.wave, lane);
    }
    __syncthreads();
}

constexpr int ST_TAB = 32, ST_STRIDE = 10;
__device__ __forceinline__ unsigned st_rd(Frame& F, int i) { return (unsigned)__builtin_amdgcn_readfirstlane((int)F.MISC[i]); }
__device__ __forceinline__ void steal_table_init(Frame& F) {
    unsigned char* ws = F.ws; const size_t l1 = (size_t)D_ * DFF;
    const float* Wp[6] = {F.w_out, F.w1, F.w2, F.fno_w, F.w1 + l1, F.w2 + l1};
    bf16* Tp[6] = {(bf16*)(ws + WS_WOUT), (bf16*)(ws + WS_W1), (bf16*)(ws + WS_W2), (bf16*)(ws + WS_WF), (bf16*)(ws + WS_W1) + l1, (bf16*)(ws + WS_W2) + l1};
    const int Kp[6] = {VW, D_, DFF, D_, D_, DFF}, Np[6] = {D_, DFF, D_, D_, DFF, D_}, Ip[6] = {PI_TWOUT, PI_TW1, PI_TW2, PI_TWF, PI_TW1, PI_TW2};
    const int Qp[6] = {CW_Q + 64, CW_Q + 128, CW_Q + 256, CW_Q + 384, CW_Q + 192, CW_Q + 320}, Lp[6] = {3, 5, 6, 11, 13, 14};
#pragma unroll
    for (int m = 0; m < 6; ++m) { volatile LAS unsigned* t = F.MISC + ST_TAB + ST_STRIDE * m; const unsigned long long w = (unsigned long long)Wp[m], q = (unsigned long long)Tp[m];
        t[0] = (unsigned)w; t[1] = (unsigned)(w >> 32); t[2] = (unsigned)q; t[3] = (unsigned)(q >> 32); t[4] = (unsigned)Kp[m]; t[5] = (unsigned)Np[m]; t[6] = (unsigned)Ip[m]; t[7] = (unsigned)Qp[m]; t[8] = (unsigned)Lp[m]; }
}
__device__ __forceinline__ void steal_conv(Frame& F, const int k, const int tid, const int lane) {
    LAS float* scr = (LAS float*)(F.lds + 32768 + F.wave * 8704);
    for (int tries = 0; tries < 6; ++tries) {
        const int m = (int)st_rd(F, 16);
        if (m >= 6) return;
        const int tb = ST_TAB + ST_STRIDE * m;
        if (k > (int)st_rd(F, tb + 8)) { __syncthreads(); if (tid == 0) F.MISC[16] = (unsigned)(m + 1); __syncthreads(); continue; }
        const float* W = (const float*)(((unsigned long long)st_rd(F, tb + 1) << 32) | st_rd(F, tb + 0));
        bf16* WT = (bf16*)(((unsigned long long)st_rd(F, tb + 3) << 32) | st_rd(F, tb + 2));
        const int K = (int)st_rd(F, tb + 4), N = (int)st_rd(F, tb + 5), nitems = (int)st_rd(F, tb + 6), qword = (int)st_rd(F, tb + 7);
        if (tid == 0) F.MISC[0] = __hip_atomic_fetch_add(F.ctl + qword, 1u, RLX_AGENT);
        __syncthreads();
        const int it = (int)F.MISC[0];
        __syncthreads();
        if (it < nitems) { tr_item(W, WT, K, N, it, scr, F.wave, lane); return; }
        if (tid == 0) F.MISC[16] = (unsigned)(m + 1);
        __syncthreads();
    }
}
__device__ __forceinline__ void xcd_barrier_steal(const XcdBarrier& b, Frame& F, const int k) {
    asm volatile("s_waitcnt vmcnt(0)" ::: "memory");
    __syncthreads();
    int tid = F.tid; asm volatile("" : "+v"(tid)); const int lane = tid & 63;
    unsigned gen = 0u;
    if (tid == 0) {
        unsigned* bar = b.bar;
        __builtin_amdgcn_s_waitcnt(0);
        unsigned nloc = b.st[0], nx = b.st[1];
        if (nloc == 0u) { xcd_barrier_complete(bar, b.x, nloc, nx); b.st[0] = nloc; b.st[1] = nx; }
        const unsigned old = xb_add(&bar[XB_XSUB(b.x)], 1u);
        gen = old / nloc;
        if (old + 1u == (gen + 1u) * nloc) {
            __builtin_amdgcn_fence(__ATOMIC_RELEASE, "agent");
            asm volatile("s_waitcnt vmcnt(0)" ::: "memory");
            __builtin_amdgcn_fence(__ATOMIC_ACQUIRE, "agent");
            const unsigned og = xb_add(&bar[XB_TOP], 1u);
            const unsigned tg = og / nx;
            if (og + 1u == (tg + 1u) * nx) xb_add(&bar[XB_TOPGEN], 1u);
            else XB_SPIN(xb_ld(&bar[XB_TOPGEN]) == tg, bar);
            asm volatile("" ::: "memory");
            xb_add(&bar[XB_XGEN(b.x)], 1u);
            asm volatile("s_waitcnt vmcnt(0)" ::: "memory");
            F.MISC[17] = 1u;
        } else {
            __builtin_amdgcn_fence(__ATOMIC_ACQUIRE, "agent");
            F.MISC[17] = 0u; F.MISC[18] = (old - gen * nloc) < (nloc >> 1) ? 1u : 0u;
        }
    }
    __syncthreads();
    if (F.MISC[17] == 0u) {
        bool may = F.MISC[18] != 0u;
        unsigned sp = 0u;
        for (;;) {
            if (tid == 0) {
                unsigned* bar = b.bar;
                bool rel = xb_ld(&bar[XB_XGEN(b.x)]) != gen;
                if (!rel) { __builtin_amdgcn_s_sleep(1); if ((++sp & 255u) == 0u) { if (xb_ld(&bar[XB_TMO])) rel = true; else if (sp > XB_SPIN_CAP) { atomicAdd(&bar[XB_TMO], 1u); rel = true; } } }
                F.MISC[17] = rel ? 1u : 0u;
            }
            __syncthreads();
            const bool rel = F.MISC[17] != 0u;
            __syncthreads();
            if (rel) break;
            if (may) { may = false; steal_conv(F, k, tid, lane); }
        }
        if (tid == 0) asm volatile("s_waitcnt vmcnt(0)" ::: "memory");
    }
    __syncthreads();
}

template <int MODE, bool XBF>
__device__ __forceinline__ void norm_phase(Frame& F, const void* xin_, const bf16* y, void* xo_, bf16* xn, const float* gate, const float* gy, const float* gn, const float* sc, const float* sh) {
    const int gw = F.bid * NWAVES + F.wave, NGW = F.G * NWAVES;
    int tid = F.tid; asm volatile("" : "+v"(tid)); const int lane = tid & 63;
    LAS float* L = (LAS float*)F.lds;
    for (int i = tid; i < D_; i += NWAVES * 64) {
        if (MODE >= 1) { L[i] = gate[i]; L[D_ + i] = gy[i]; }
        if (MODE <= 1) { L[2 * D_ + i] = gn[i]; L[3 * D_ + i] = sc[i] + 1.0f; L[4 * D_ + i] = sh[i]; }
    }
    __syncthreads();
    const LAS float* Ll = L + 8 * lane;
#define NP_UNPK(pk_, o_) do { (o_)[0] = bf_lo((pk_).x); (o_)[1] = bf_hi((pk_).x); (o_)[2] = bf_lo((pk_).y); (o_)[3] = bf_hi((pk_).y); (o_)[4] = bf_lo((pk_).z); (o_)[5] = bf_hi((pk_).z); (o_)[6] = bf_lo((pk_).w); (o_)[7] = bf_hi((pk_).w); } while (0)
#pragma unroll 1
    for (int row = gw; row < S_; row += NGW) {
        const size_t ro = (size_t)row * D_ + 8 * lane;
        float xv[8][8];
        if (XBF) {
            v4u xp[8];
#pragma unroll
            for (int k = 0; k < 8; ++k) xp[k] = *(const GAS v4u*)((const bf16*)xin_ + ro + 512 * k);
#pragma unroll
            for (int k = 0; k < 8; ++k) NP_UNPK(xp[k], xv[k]);
        } else {
#pragma unroll
            for (int k = 0; k < 8; ++k) { const f32x4 a = *(const GAS f32x4*)((const float*)xin_ + ro + 512 * k), b = *(const GAS f32x4*)((const float*)xin_ + ro + 512 * k + 4);
                xv[k][0] = a.x; xv[k][1] = a.y; xv[k][2] = a.z; xv[k][3] = a.w; xv[k][4] = b.x; xv[k][5] = b.y; xv[k][6] = b.z; xv[k][7] = b.w; }
        }
        if (MODE >= 1) {
            v4u yp[8]; float ss = 0.f;
#pragma unroll
            for (int k = 0; k < 8; ++k) yp[k] = *(const GAS v4u*)(y + ro + 512 * k);
#pragma unroll
            for (int k = 0; k < 8; ++k) { float t[8]; NP_UNPK(yp[k], t); ss += ((t[0] * t[0] + t[1] * t[1]) + (t[2] * t[2] + t[3] * t[3])) + ((t[4] * t[4] + t[5] * t[5]) + (t[6] * t[6] + t[7] * t[7])); }
            const float rs = 1.0f / sqrtf(wave_sum(ss) * (1.f / D_) + EPS_);
#pragma unroll
            for (int k = 0; k < 8; ++k) asm volatile("" : "+v"(yp[k].x), "+v"(yp[k].y), "+v"(yp[k].z), "+v"(yp[k].w));
#pragma unroll
            for (int k = 0; k < 8; ++k) {
                const f32x4 g0 = *(const LAS f32x4*)(Ll + 512 * k), g1 = *(const LAS f32x4*)(Ll + 512 * k + 4), w0 = *(const LAS f32x4*)(Ll + D_ + 512 * k), w1 = *(const LAS f32x4*)(Ll + D_ + 512 * k + 4);
                const float gg[8] = {g0.x, g0.y, g0.z, g0.w, g1.x, g1.y, g1.z, g1.w}, ww[8] = {w0.x, w0.y, w0.z, w0.w, w1.x, w1.y, w1.z, w1.w};
                float t[8]; NP_UNPK(yp[k], t);
#pragma unroll
                for (int e = 0; e < 8; ++e) xv[k][e] = xv[k][e] + gg[e] * ((t[e] * rs) * ww[e]);
                if (MODE == 2) { *(GAS f32x4*)((float*)xo_ + ro + 512 * k) = (f32x4){xv[k][0], xv[k][1], xv[k][2], xv[k][3]}; *(GAS f32x4*)((float*)xo_ + ro + 512 * k + 4) = (f32x4){xv[k][4], xv[k][5], xv[k][6], xv[k][7]}; }
                else { v4u o; o.x = pk2(xv[k][0], xv[k][1]); o.y = pk2(xv[k][2], xv[k][3]); o.z = pk2(xv[k][4], xv[k][5]); o.w = pk2(xv[k][6], xv[k][7]); *(GAS v4u*)((bf16*)xo_ + ro + 512 * k) = o; }
                if ((k & 1) == 1) __builtin_amdgcn_sched_barrier(0); }
        }
        if (MODE <= 1) {
            float ss = 0.f;
#pragma unroll
            for (int k = 0; k < 8; ++k) ss += ((xv[k][0] * xv[k][0] + xv[k][1] * xv[k][1]) + (xv[k][2] * xv[k][2] + xv[k][3] * xv[k][3])) + ((xv[k][4] * xv[k][4] + xv[k][5] * xv[k][5]) + (xv[k][6] * xv[k][6] + xv[k][7] * xv[k][7]));
            const float rs = 1.0f / sqrtf(wave_sum(ss) * (1.f / D_) + EPS_);
#pragma unroll
            for (int k = 0; k < 8; ++k) {
                float h[8];
#pragma unroll
                for (int q = 0; q < 2; ++q) { const f32x4 w = *(const LAS f32x4*)(Ll + 2 * D_ + 512 * k + 4 * q), a = *(const LAS f32x4*)(Ll + 3 * D_ + 512 * k + 4 * q), b = *(const LAS f32x4*)(Ll + 4 * D_ + 512 * k + 4 * q);
                    h[4 * q] = ((xv[k][4 * q] * rs) * w.x) * a.x + b.x; h[4 * q + 1] = ((xv[k][4 * q + 1] * rs) * w.y) * a.y + b.y; h[4 * q + 2] = ((xv[k][4 * q + 2] * rs) * w.z) * a.z + b.z; h[4 * q + 3] = ((xv[k][4 * q + 3] * rs) * w.w) * a.w + b.w; }
                v4u o; o.x = pk2(h[0], h[1]); o.y = pk2(h[2], h[3]); o.z = pk2(h[4], h[5]); o.w = pk2(h[6], h[7]); *(GAS v4u*)(xn + ro + 512 * k) = o;
                if ((k & 1) == 1) __builtin_amdgcn_sched_barrier(0); }
        }
    }
#undef NP_UNPK
    __syncthreads();
}

template <int NB> __device__ __forceinline__ void dma_blocks(const void* gsrc, LAS unsigned char* ldst, int tid, int wave) {
#pragma unroll
    for (int i = 0; i < NB; ++i) __builtin_amdgcn_global_load_lds((const unsigned*)((const char*)gsrc + i * 8192 + tid * 16), (LAS unsigned*)(ldst + i * 8192 + wave * 1024), 16, 0, 0);
}
#define STAGE_SYNC() do { asm volatile("s_waitcnt vmcnt(0) lgkmcnt(0)" ::: "memory"); __builtin_amdgcn_s_barrier(); asm volatile("" ::: "memory"); } while (0)

__device__ __forceinline__ void rs_phase(Frame& F) {
    const bf16* KFT = (const bf16*)(F.ws + WS_KFT); const bf16* KBT = (const bf16*)(F.ws + WS_KBT); const bf16* VT = (const bf16*)(F.ws + WS_VT); bf16* ST = (bf16*)(F.ws + WS_ST);
    int tid = F.tid; asm volatile("" : "+v"(tid)); const int lane = tid & 63;
    const int r = lane & 31, hh = lane >> 5, w = F.wave, wa = w >> 1, wb = w & 1;
    LAS unsigned char* L = F.lds;
    constexpr int SB = 32768;
    const unsigned aoff = (unsigned)(hh * 2048 + (32 * wa + r) * 16);
    const unsigned boff = (unsigned)(16384 + hh * 2048 + (64 * wb + r) * 16);
    const int vb = (F.G % 8 == 0) ? (F.bid % 8) * (F.G / 8) + F.bid / 8 : F.bid;
    for (int job = vb; job < H_ * 2 * 2 * 4; job += F.G) {
        const int h = job >> 4, d = (job >> 3) & 1, dh = (job >> 2) & 1, e = job & 3;
        const float l2 = pg8::lg2_sigmoid(d ? F.decb[h] : F.decf[h]);
        const float cdec = __builtin_amdgcn_exp2f((float)pg8::RC * l2);
        f32x16 acc[2];
#pragma unroll
        for (int t = 0; t < 2; ++t)
#pragma unroll
            for (int i = 0; i < 16; ++i) acc[t][i] = 0.f;
        const bf16* KT = d ? KBT : KFT;
        const int pidx = ((w >> 2) * 2 + ((w >> 1) & 1)) * 2 + (w & 1);
        const size_t kpiece = ((size_t)pidx * 256 + 128 * dh + lane) * 8, vpiece = ((size_t)pidx * 512 + 128 * e + lane) * 8;
#define RS_ISSUE(step_, sub_, buf_) do { const int c_ = d ? (NCH - 1 - (step_)) : (step_); const size_t tb_ = (size_t)(h * 256 + c_ * 8 + 2 * (sub_)); \
        LAS unsigned char* lb_ = L + (buf_) * SB + w * 2048; \
        __builtin_amdgcn_global_load_lds((const unsigned*)(KT + tb_ * 8192 + kpiece), (LAS unsigned*)(lb_), 16, 0, 0); \
        __builtin_amdgcn_global_load_lds((const unsigned*)(KT + tb_ * 8192 + kpiece + 512), (LAS unsigned*)(lb_ + 1024), 16, 0, 0); \
        __builtin_amdgcn_global_load_lds((const unsigned*)(VT + tb_ * 16384 + vpiece), (LAS unsigned*)(lb_ + 16384), 16, 0, 0); \
        __builtin_amdgcn_global_load_lds((const unsigned*)(VT + tb_ * 16384 + vpiece + 512), (LAS unsigned*)(lb_ + 16384 + 1024), 16, 0, 0); } while (0)
        RS_ISSUE(0, 0, 0); RS_ISSUE(0, 1, 1);
        int bcur = 0;
#pragma unroll 1
        for (int step = 0; step < NCH; ++step) {
            const int c = d ? (NCH - 1 - step) : step;
#pragma unroll
            for (int sub = 0; sub < 4; ++sub) {
                if (step == NCH - 1 && sub == 3) asm volatile("s_waitcnt vmcnt(0) lgkmcnt(0)" ::: "memory"); else asm volatile("s_waitcnt vmcnt(4) lgkmcnt(0)" ::: "memory");
                __builtin_amdgcn_s_barrier(); asm volatile("" ::: "memory");
                { const int bn = bcur >= 1 ? bcur - 1 : 2;
                  if (sub < 2) RS_ISSUE(step, sub + 2, bn); else if (step + 1 < NCH) RS_ISSUE(step + 1, sub - 2, bn); }
                if (sub == 0) {
                    bf16* so = ST + ((((size_t)((h * NCH + c) * 2 + d) * 8 + 4 * dh + wa) * 4) * 512 + 128 * e + 64 * wb + r) * 8 + 4 * hh;
#pragma unroll
                    for (int t = 0; t < 2; ++t)
#pragma unroll
                        for (int g4 = 0; g4 < 4; ++g4) { v2u o; o.x = pk2(acc[t][4 * g4], acc[t][4 * g4 + 1]); o.y = pk2(acc[t][4 * g4 + 2], acc[t][4 * g4 + 3]);
                            *(GAS v2u*)(so + ((size_t)g4 * 512 + 32 * t) * 8) = o; }
#pragma unroll
                    for (int t = 0; t < 2; ++t)
#pragma unroll
                        for (int i = 0; i < 16; ++i) acc[t][i] *= cdec;
                }
                const LAS unsigned char* B = L + bcur * SB;
#pragma unroll
                for (int kbi = 0; kbi < 2; ++kbi)
#pragma unroll
                    for (int s2 = 0; s2 < 2; ++s2) {
                        const bf16x8 a = *(const LAS bf16x8*)(B + aoff + (kbi * 2 + s2) * 4096);
                        const bf16x8 b0 = *(const LAS bf16x8*)(B + boff + (kbi * 2 + s2) * 4096), b1 = *(const LAS bf16x8*)(B + boff + (kbi * 2 + s2) * 4096 + 512);
                        acc[0] = __builtin_amdgcn_mfma_f32_32x32x16_bf16(a, b0, acc[0], 0, 0, 0);
                        acc[1] = __builtin_amdgcn_mfma_f32_32x32x16_bf16(a, b1, acc[1], 0, 0, 0);
                    }
                bcur = bcur == 2 ? 0 : bcur + 1;
            }
        }
#undef RS_ISSUE
        asm volatile("s_waitcnt lgkmcnt(0)" ::: "memory"); __builtin_amdgcn_s_barrier(); asm volatile("" ::: "memory");
    }
}

__device__ __forceinline__ void r3_phase(Frame& F) {
    const bf16* Q0 = (const bf16*)(F.ws + WS_Q0); const bf16* K0 = (const bf16*)(F.ws + WS_K0);
    const bf16* VT = (const bf16*)(F.ws + WS_VT); const bf16* ST = (const bf16*)(F.ws + WS_ST); const bf16* SG = (const bf16*)(F.ws + WS_SG); bf16* A2 = (bf16*)(F.ws + WS_A2);
    LAS unsigned char* L = F.lds;
    constexpr int QL = 98304, NQL = 12, NGR = 56, NSLOT = 6, AHEAD = 5;
    LAS float* red = (LAS float*)(F.lds + 147456);
    LAS float* gnl = (LAS float*)(F.lds + 149504);
    int tid = F.tid; asm volatile("" : "+v"(tid)); const int lane = tid & 63;
    const int r = lane & 31, hh = lane >> 5, w = F.wave, wr = w >> 1, wc = w & 1;
    const unsigned koff = (unsigned)(hh * 512 + r * 16);
    const unsigned voff = (unsigned)(hh * 8192 + wc * 4096 + r * 16);
    const unsigned qoff = (unsigned)(QL + wr * (NQL * 1024) + hh * 512 + r * 16);
    const int NU = H_ * (S_ / 128);
#define R3_GRAN(uu_, n_, sl_) do { const int hq_ = (uu_) >> 6, cq_ = ((uu_) & 63) >> 1; const bf16* src_; \
        if ((n_) < 32) { const int d_ = 1 - ((n_) >> 4), s8_ = ((n_) >> 1) & 7; src_ = ST + ((size_t)((hq_ * NCH + cq_) * 2 + d_) * 8 + s8_) * 16384 + ((n_) & 1) * 8192; } \
        else { const int m_ = (n_) - 32, kb_ = m_ / 3, pt_ = m_ - 3 * kb_; const size_t tb_ = (size_t)(hq_ * 256 + cq_ * 8 + kb_); src_ = pt_ == 0 ? K0 + tb_ * 8192 : VT + tb_ * 16384 + (pt_ - 1) * 8192; } \
        dma_blocks<2>(src_, L + (sl_) * 16384, tid, w); } while (0)
#define R3_ISSUE_Q(uu_) do { _Pragma("unroll") for (int p_ = 0; p_ < 6; ++p_) { const int pc_ = 6 * w + p_, g_ = pc_ / NQL, i_ = pc_ % NQL; \
        __builtin_amdgcn_global_load_lds((const unsigned*)(Q0 + ((size_t)(((uu_) >> 6) * 256 + ((uu_) & 63) * 4 + g_) * 16 + i_) * 512 + lane * 8), (LAS unsigned*)(L + QL + g_ * (NQL * 1024) + i_ * 1024), 16, 0, 0); } } while (0)
#define R3_STEP(n_, drain_) do { if (drain_) asm volatile("s_waitcnt vmcnt(0) lgkmcnt(0)" ::: "memory"); else asm volatile("s_waitcnt vmcnt(8) lgkmcnt(0)" ::: "memory"); \
        __builtin_amdgcn_s_barrier(); asm volatile("" ::: "memory"); \
        { const int gi_ = (n_) + AHEAD; const int fs_ = slot == 0 ? NSLOT - 1 : slot - 1; \
          if (gi_ < NGR) R3_GRAN(u, gi_, fs_); else if (has_next) R3_GRAN(u + F.G, gi_ - NGR, fs_); } } while (0)
    int u = (F.G % 8 == 0) ? (F.bid % 8) * (F.G / 8) + F.bid / 8 : F.bid;
    int slot = 0;
    if (u < NU) {
#pragma unroll
        for (int g = 0; g < AHEAD; ++g) R3_GRAN(u, g, g);
        R3_ISSUE_Q(u);
    }
#pragma unroll 1
    for (; u < NU; u += F.G) {
        const int h = u >> 6, qb = u & 63;
        const int tq = qb * 128 + 32 * wr + r, jq = tq & (pg8::RC - 1);
        const bool has_next = (u + F.G) < NU;
        const float lf2 = pg8::lg2_sigmoid(F.decf[h]), lb2 = pg8::lg2_sigmoid(F.decb[h]);
        const size_t qfo = ((size_t)(h * 256 + qb * 4 + wr) * 1024 + hh * 32 + r) * 8;
        bf16x8 qr[16 - NQL];
#pragma unroll
        for (int i = 0; i < 16 - NQL; ++i) qr[i] = *(const GAS bf16x8*)(Q0 + qfo + (NQL + i) * 512);
        f32x16 acc[8];
#pragma unroll
        for (int t = 0; t < 8; ++t)
#pragma unroll
            for (int i = 0; i < 16; ++i) acc[t][i] = 0.f;
        const float qfs = __builtin_amdgcn_exp2f((float)(jq + 1) * lf2), qbs = __builtin_amdgcn_exp2f((float)(pg8::RC - jq) * lb2);
#pragma unroll 1
        for (int dd = 0; dd < 2; ++dd) {
#pragma unroll
            for (int sl = 0; sl < 8; ++sl)
#pragma unroll
                for (int k2 = 0; k2 < 2; ++k2) {
                    const int n = dd * 16 + sl * 2 + k2;
                    R3_STEP(n, n == 0);
                    const LAS unsigned char* B = L + slot * 16384;
                    const int ks = 2 * sl + k2;
                    bf16x8 qv; if (ks < NQL) qv = *(const LAS bf16x8*)(L + qoff + ks * 1024); else qv = qr[ks < NQL ? 0 : ks - NQL];
#pragma unroll
                    for (int t = 0; t < 8; ++t) { const bf16x8 a = *(const LAS bf16x8*)(B + voff + t * 512);
                        acc[t] = __builtin_amdgcn_mfma_f32_32x32x16_bf16(a, qv, acc[t], 0, 0, 0); if ((t & 3) == 3) __builtin_amdgcn_sched_barrier(0); }
                    slot = slot == NSLOT - 1 ? 0 : slot + 1;
                }
            const float scl = dd == 0 ? qbs / qfs : qfs;
#pragma unroll
            for (int t = 0; t < 8; ++t)
#pragma unroll
                for (int i = 0; i < 16; ++i) acc[t][i] *= scl;
        }
#pragma unroll 1
        for (int kb = 0; kb < 8; ++kb) {
            const int n0 = 32 + 3 * kb;
            const bool tail = !has_next && n0 + 2 + (AHEAD - 1) >= NGR;
            R3_STEP(n0, tail);
            bf16x8 pf[2];
            {
                const LAS unsigned char* B = L + slot * 16384;
                f32x16 sc;
#pragma unroll
                for (int i = 0; i < 16; ++i) sc[i] = 0.f;
#pragma unroll
                for (int ks = 0; ks < NQL; ++ks) { const bf16x8 a = *(const LAS bf16x8*)(B + koff + ks * 1024), b = *(const LAS bf16x8*)(L + qoff + ks * 1024);
                    sc = __builtin_amdgcn_mfma_f32_32x32x16_bf16(a, b, sc, 0, 0, 0); if ((ks & 1) == 1) __builtin_amdgcn_sched_barrier(0); }
#pragma unroll
                for (int ks = NQL; ks < 16; ++ks) { const bf16x8 a = *(const LAS bf16x8*)(B + koff + ks * 1024); sc = __builtin_amdgcn_mfma_f32_32x32x16_bf16(a, qr[ks - NQL], sc, 0, 0, 0); }
#pragma unroll
                for (int i = 0; i < 16; ++i) { const int jm = 32 * kb + (i & 3) + 8 * (i >> 2) + 4 * hh; const int df = jq - jm;
                    const float dm = df > 0 ? __builtin_amdgcn_exp2f((float)df * lf2) : (df < 0 ? __builtin_amdgcn_exp2f((float)(-df) * lb2) : 2.0f); sc[i] *= dm; }
#pragma unroll
                for (int s2 = 0; s2 < 2; ++s2) { v4u p; p.x = pk2(sc[8 * s2], sc[8 * s2 + 1]); p.y = pk2(sc[8 * s2 + 2], sc[8 * s2 + 3]); p.z = pk2(sc[8 * s2 + 4], sc[8 * s2 + 5]); p.w = pk2(sc[8 * s2 + 6], sc[8 * s2 + 7]); pf[s2] = __builtin_bit_cast(bf16x8, p); }
                slot = slot == NSLOT - 1 ? 0 : slot + 1;
            }
#pragma unroll
            for (int s2 = 0; s2 < 2; ++s2) {
                R3_STEP(n0 + 1 + s2, tail);
                const LAS unsigned char* B = L + slot * 16384;
#pragma unroll
                for (int t = 0; t < 8; ++t) { const bf16x8 av = *(const LAS bf16x8*)(B + voff + t * 512);
                    acc[t] = __builtin_amdgcn_mfma_f32_32x32x16_bf16(av, pf[s2], acc[t], 0, 0, 0); if ((t & 3) == 3) __builtin_amdgcn_sched_barrier(0); }
                slot = slot == NSLOT - 1 ? 0 : slot + 1;
            }
        }
        const int cb = h * DV + 256 * wc + 4 * hh;
        const bf16* sg = SG + (size_t)tq * VW + cb; bf16* ao = A2 + (size_t)tq * VW + cb;
        v2u gwv[32];
#pragma unroll
        for (int t = 0; t < 8; ++t)
#pragma unroll
            for (int g4 = 0; g4 < 4; ++g4) gwv[4 * t + g4] = *(const GAS v2u*)(sg + 32 * t + 8 * g4);
        gnl[tid] = F.gn_g[h * DV + tid];
        float s1 = 0.f;
#pragma unroll
        for (int t = 0; t < 8; ++t)
#pragma unroll
            for (int i = 0; i < 16; ++i) s1 += acc[t][i];
        s1 += __shfl_xor(s1, 32);
        if (hh == 0) red[(wr * 2 + wc) * 32 + r] = s1;
        __syncthreads();
        if (has_next) R3_ISSUE_Q(u + F.G);
        const float mean = (red[(wr * 2) * 32 + r] + red[(wr * 2 + 1) * 32 + r]) * (1.f / DV);
        float s2 = 0.f;
#pragma unroll
        for (int t = 0; t < 8; ++t)
#pragma unroll
            for (int i = 0; i < 16; ++i) { const float dlt = acc[t][i] - mean; s2 += dlt * dlt; }
        s2 += __shfl_xor(s2, 32);
        if (hh == 0) red[256 + (wr * 2 + wc) * 32 + r] = s2;
        __syncthreads();
        const float rstd = 1.0f / sqrtf((red[256 + (wr * 2) * 32 + r] + red[256 + (wr * 2 + 1) * 32 + r]) * (1.f / DV) + EPS_);
        const LAS float* gg = gnl + 256 * wc + 4 * hh;
#pragma unroll
        for (int t = 0; t < 8; ++t) {
#pragma unroll
            for (int g4 = 0; g4 < 4; ++g4) {
                const int o = 32 * t + 8 * g4;
                const v2u gw = gwv[4 * t + g4]; const f32x4 gv = *(const LAS f32x4*)(gg + o);
                const float y0 = (acc[t][4 * g4] - mean) * rstd * gv.x * bf_lo(gw.x), y1 = (acc[t][4 * g4 + 1] - mean) * rstd * gv.y * bf_hi(gw.x);
                const float y2 = (acc[t][4 * g4 + 2] - mean) * rstd * gv.z * bf_lo(gw.y), y3 = (acc[t][4 * g4 + 3] - mean) * rstd * gv.w * bf_hi(gw.y);
                v2u ov; ov.x = pk2(y0, y1); ov.y = pk2(y2, y3); *(GAS v2u*)(ao + o) = ov;
            }
            if (t & 1) __builtin_amdgcn_sched_barrier(0); }
    }
#undef R3_GRAN
#undef R3_STEP
#undef R3_ISSUE_Q
    asm volatile("s_waitcnt vmcnt(0) lgkmcnt(0)" ::: "memory"); __syncthreads();
}

__device__ constexpr float W32C[16] = {1.000000000f, 0.980785280f, 0.923879533f, 0.831469612f, 0.707106781f, 0.555570233f, 0.382683432f, 0.195090322f, 0.000000000f, -0.195090322f, -0.382683432f, -0.555570233f, -0.707106781f, -0.831469612f, -0.923879533f, -0.980785280f};
__device__ constexpr float W32S[16] = {0.000000000f, 0.195090322f, 0.382683432f, 0.555570233f, 0.707106781f, 0.831469612f, 0.923879533f, 0.980785280f, 1.000000000f, 0.980785280f, 0.923879533f, 0.831469612f, 0.707106781f, 0.555570233f, 0.382683432f, 0.195090322f};
__host__ __device__ constexpr int brev5(int p) { return ((p & 1) << 4) | ((p & 2) << 2) | (p & 4) | ((p & 8) >> 2) | ((p & 16) >> 4); }
__device__ __forceinline__ void ffta_phase(Frame& F) {
    const bf16* Yt = (const bf16*)(F.ws + WS_YT); bf16* Gm = (bf16*)(F.ws + WS_G);
    int tid = F.tid; asm volatile("" : "+v"(tid));
#pragma unroll 1
    for (int idx = F.bid * (NWAVES * 64) + tid; idx < D_ * 256; idx += F.G * (NWAVES * 64)) {
        const int col = idx >> 8, s2 = idx & 255;
        const GAS bf16* src = (const GAS bf16*)(Yt + (size_t)col * 16384 + s2);
        float xr[32], xi[32];
#pragma unroll
        for (int s1 = 0; s1 < 32; ++s1) { xr[s1] = __builtin_bit_cast(float, (unsigned)src[256 * s1] << 16); xi[s1] = -__builtin_bit_cast(float, (unsigned)src[8192 + 256 * s1] << 16); }
#pragma unroll
        for (int len = 32; len >= 2; len >>= 1) {
            const int half = len >> 1, step = 32 / len;
#pragma unroll
            for (int i = 0; i < 32; i += len)
#pragma unroll
                for (int j = 0; j < half; ++j) {
                    const float ar = xr[i + j], ai = xi[i + j], br = xr[i + j + half], bi = xi[i + j + half];
                    xr[i + j] = ar + br; xi[i + j] = ai + bi;
                    const float dr = ar - br, di = ai - bi, c = W32C[j * step], sn = W32S[j * step];
                    xr[i + j + half] = dr * c + di * sn; xi[i + j + half] = di * c - dr * sn;
                }
        }
        GAS bf16* dst = (GAS bf16*)(Gm + (size_t)col * 512 + s2);
#pragma unroll
        for (int p = 0; p < 32; ++p) {
            const int k = brev5(p);
            const float rev = (float)((s2 * k) & 8191) * (1.f / 8192.f); const float c = cos_rev(rev), sn = sin_rev(rev);
            const float gr = xr[p] * c + xi[p] * sn, gi = xi[p] * c - xr[p] * sn;
            dst[(size_t)k * (D_ * 512)] = pg8::f2bf1(gr); dst[(size_t)k * (D_ * 512) + 256] = pg8::f2bf1(gi);
        }
    }
}

constexpr int NPH = 18;
__global__ void __launch_bounds__(NWAVES * 64, 2) enc_fwd(Args args) {
    extern __shared__ __attribute__((aligned(16))) unsigned char lds[];
    Frame F;
    F.lds = (LAS unsigned char*)lds; F.MISC = (volatile LAS unsigned*)(F.lds + MISC_OFF);
    F.tid = threadIdx.x; F.wave = __builtin_amdgcn_readfirstlane(F.tid >> 6); F.G = gridDim.x; F.bid = blockIdx.x;
    F.ws = args.ws; F.ctl = (unsigned*)(args.ws + WS_CTL);
    F.x = args.in[0]; F.c = args.in[1]; F.ada_w = args.in[2]; F.ada_b = args.in[3]; F.norm_g = args.in[4]; F.w_in = args.in[5]; F.w_out = args.in[6]; F.gn_g = args.in[7];
    F.decf = args.in[8]; F.decb = args.in[9]; F.fno_w = args.in[10]; F.fno_b = args.in[11]; F.w1 = args.in[12]; F.w2 = args.in[13]; F.out = args.out;
    for (int u = F.tid; u < (LDS_BYTES - LDSCTL_OFF) / 4; u += NWAVES * 64) ((LAS unsigned*)(F.lds + LDSCTL_OFF))[u] = 0u;
    __syncthreads();
    if (F.tid == 0) steal_table_init(F);
    __syncthreads();
    const int lo = args.ph_lo, hi = args.ph_hi;
    XcdBarrier bar; bar.bar = (unsigned*)(F.ctl + CW_BAR) + args.li * XCD_BAR_WORDS; bar.x = 0; bar.st = nullptr;
    if (hi - lo > 1) bar = xcd_barrier_post((unsigned*)(F.ctl + CW_BAR) + args.li * XCD_BAR_WORDS, F.MISC + 8);
#ifndef PHMASK
#define PHMASK 0x3ffff
#endif
#define IN(k) (((PHMASK >> (k)) & 1) && lo <= (k) && (k) < hi)
#define SEAM(k) do { if (IN(k) && IN((k) + 1)) { if ((k) <= 14) xcd_barrier_steal(bar, F, (k)); else xcd_barrier(bar); } } while (0)
    unsigned char* ws = args.ws;
    const float* MOD = (const float*)(ws + WS_MOD);
    bf16* XN = (bf16*)(ws + WS_XN); bf16* XA = (bf16*)(ws + WS_XA); bf16* Y = (bf16*)(ws + WS_Y); bf16* HB = (bf16*)(ws + WS_HB);
    const float* NG = F.norm_g;
#define MODV(l, i) (MOD + (size_t)(l) * NMOD + (i) * D_)
#define NGV(l, i) (NG + ((l) * 4 + (i)) * D_)

    if (IN(0)) { p0_prologue(F, CW_Q); } SEAM(0);
    if (IN(1)) { norm_phase<0, false>(F, F.x, nullptr, nullptr, XN, nullptr, nullptr, NGV(0, 0), MODV(0, 1), MODV(0, 0)); } SEAM(1);
    if (IN(2)) {
        pg8::Gemm g{XN, (const bf16*)(ws + WS_WIN), D_, D_, D_, 0, 0}; pg8::StaticOrder S; S.init(S_, WIN, F.G, F.bid);
        pg8::EpiWin E{(bf16*)(ws + WS_Q0), (bf16*)(ws + WS_K0), (bf16*)(ws + WS_KFT), (bf16*)(ws + WS_KBT), (bf16*)(ws + WS_VT), (bf16*)(ws + WS_SG),
                      F.decf, F.decb, S_, F.lds + 131072};
        pg8::gemm_phase<pg8::EpiWin, pg8::StaticOrder, PG8_ALIGN, PG8_SP2>(F.lds + RING_OFF, g, S, E);
    } SEAM(2);
    if (IN(3)) { rs_phase(F); } SEAM(3);
    if (IN(4)) { r3_phase(F); conv_phase(F, F.w_out, (bf16*)(ws + WS_WOUT), VW, D_, PI_TWOUT, CW_Q + 64); } SEAM(4);
    if (IN(5)) {
        pg8::Gemm g{(const bf16*)(ws + WS_A2), (const bf16*)(ws + WS_WOUT), VW, VW, VW, 0, 0}; pg8::StaticOrder S; S.init(S_, D_, F.G, F.bid);
        pg8::EpiBf16<0> E{Y, D_, nullptr};
        pg8::gemm_phase<pg8::EpiBf16<0>, pg8::StaticOrder, PG8_ALIGN, PG8_SP2>(F.lds + RING_OFF, g, S, E);
    } SEAM(5);
    if (IN(6)) { norm_phase<1, false>(F, F.x, Y, XA, XN, MODV(0, 2), NGV(0, 1), NGV(0, 2), MODV(0, 4), MODV(0, 3)); conv_phase(F, F.w1, (bf16*)(ws + WS_W1), D_, DFF, PI_TW1, CW_Q + 128); } SEAM(6);
    if (IN(7)) {
        pg8::Gemm g{XN, (const bf16*)(ws + WS_W1), D_, D_, D_, 0, 0}; pg8::StaticOrder S; S.init(S_, DFF, F.G, F.bid);
        pg8::EpiBf16<1> E{HB, DFF, nullptr};
        pg8::gemm_phase<pg8::EpiBf16<1>, pg8::StaticOrder, PG8_ALIGN, PG8_SP2>(F.lds + RING_OFF, g, S, E);
        conv_phase(F, F.w2, (bf16*)(ws + WS_W2), DFF, D_, PI_TW2, CW_Q + 256);
    } SEAM(7);
    if (IN(8)) {
        pg8::Gemm g{HB, (const bf16*)(ws + WS_W2), DFF, DFF, DFF, 0, 0}; pg8::StaticOrder S; S.init(S_, D_, F.G, F.bid);
        pg8::EpiBf16<0> E{Y, D_, nullptr};
        pg8::gemm_phase<pg8::EpiBf16<0>, pg8::StaticOrder, PG8_ALIGN, PG8_SP2>(F.lds + RING_OFF, g, S, E);
    } SEAM(8);
    if (IN(9)) { norm_phase<1, true>(F, XA, Y, XA, XN, MODV(0, 5), NGV(0, 3), NGV(1, 0), MODV(1, 1), MODV(1, 0)); } SEAM(9);
    if (IN(10)) {
        pg8::Gemm g{(const bf16*)(ws + WS_T512), XN, 512, D_, 512, 0, 512}; pg8::BatchOrder S; S.init(1024, S_, 8, F.G, F.bid);
        pg8::EpiFft1 E{(bf16*)(ws + WS_YT)};
        pg8::gemm_phase<pg8::EpiFft1, pg8::BatchOrder, PG8_ALIGN, PG8_SP2>(F.lds + RING_OFF, g, S, E);
    } SEAM(10);
    if (IN(11)) { ffta_phase(F); } SEAM(11);
    if (IN(12)) {
        pg8::Gemm g{(const bf16*)(ws + WS_AB), (const bf16*)(ws + WS_G), 512, 512, 512, 0, (size_t)D_ * 512}; pg8::BatchOrder S; S.init(256, D_, 32, F.G, F.bid);
        pg8::EpiMixB E{(bf16*)(ws + WS_MIX)};
        pg8::gemm_phase<pg8::EpiMixB, pg8::BatchOrder, PG8_ALIGN, PG8_SP2>(F.lds + RING_OFF, g, S, E);
        conv_phase(F, F.fno_w, (bf16*)(ws + WS_WF), D_, D_, PI_TWF, CW_Q + 384);
    } SEAM(12);
    if (IN(13)) {
        pg8::Gemm g{(const bf16*)(ws + WS_MIX), (const bf16*)(ws + WS_WF), D_, D_, D_, 0, 0}; pg8::StaticOrder S; S.init(S_, D_, F.G, F.bid);
        pg8::EpiBf16<0> E{Y, D_, F.fno_b};
        pg8::gemm_phase<pg8::EpiBf16<0>, pg8::StaticOrder, PG8_ALIGN, PG8_SP2>(F.lds + RING_OFF, g, S, E);
    } SEAM(13);
    if (IN(14)) { norm_phase<1, true>(F, XA, Y, XA, XN, MODV(1, 2), NGV(1, 1), NGV(1, 2), MODV(1, 4), MODV(1, 3)); conv_phase(F, F.w1 + (size_t)D_ * DFF, (bf16*)(ws + WS_W1) + (size_t)D_ * DFF, D_, DFF, PI_TW1, CW_Q + 192); } SEAM(14);
    if (IN(15)) {
        pg8::Gemm g{XN, (const bf16*)(ws + WS_W1) + (size_t)D_ * DFF, D_, D_, D_, 0, 0}; pg8::StaticOrder S; S.init(S_, DFF, F.G, F.bid);
        pg8::EpiBf16<1> E{HB, DFF, nullptr};
        pg8::gemm_phase<pg8::EpiBf16<1>, pg8::StaticOrder, PG8_ALIGN, PG8_SP2>(F.lds + RING_OFF, g, S, E);
        conv_phase(F, F.w2 + (size_t)D_ * DFF, (bf16*)(ws + WS_W2) + (size_t)D_ * DFF, DFF, D_, PI_TW2, CW_Q + 320);
    } SEAM(15);
    if (IN(16)) {
        pg8::Gemm g{HB, (const bf16*)(ws + WS_W2) + (size_t)D_ * DFF, DFF, DFF, DFF, 0, 0}; pg8::StaticOrder S; S.init(S_, D_, F.G, F.bid);
        pg8::EpiBf16<0> E{Y, D_, nullptr};
        pg8::gemm_phase<pg8::EpiBf16<0>, pg8::StaticOrder, PG8_ALIGN, PG8_SP2>(F.lds + RING_OFF, g, S, E);
    } SEAM(16);
    if (IN(17)) { norm_phase<2, true>(F, XA, Y, F.out, nullptr, MODV(1, 5), NGV(1, 3), nullptr, nullptr, nullptr); }
#undef IN
#undef SEAM
}

extern "C" void kernel_launch(void* const* d_in, const int* in_sizes, int n_in, void* d_out, int out_size, void* d_ws, size_t ws_size, hipStream_t stream) {
    static int grid = 0;
    if (grid == 0) {
        if (n_in != 14 || out_size != S_ * D_ || ws_size < WS_END) { fprintf(stderr, "kernel_launch: unexpected problem (n_in %d, out %d, ws %zu < %zu)\n", n_in, out_size, ws_size, (size_t)WS_END); grid = -1; return; }
        int dev = 0, cus = 0, per_cu = 0;
        if (hipGetDevice(&dev) != hipSuccess || hipDeviceGetAttribute(&cus, hipDeviceAttributeMultiprocessorCount, dev) != hipSuccess) { grid = -1; return; }
        if (hipFuncSetAttribute((const void*)enc_fwd, hipFuncAttributeMaxDynamicSharedMemorySize, LDS_BYTES) != hipSuccess) { fprintf(stderr, "kernel_launch: hipFuncSetAttribute failed\n"); grid = -1; return; }
        if (hipOccupancyMaxActiveBlocksPerMultiprocessor(&per_cu, (const void*)enc_fwd, NWAVES * 64, LDS_BYTES) != hipSuccess || per_cu < 1) fprintf(stderr, "kernel_launch: occupancy query reports %d\n", per_cu);
        (void)hipGetLastError();
        grid = cus;
    }
    if (grid < 0) return;
    (void)hipMemsetAsync((char*)d_ws + WS_CTL, 0, CTL_ZERO_BYTES, stream);
    Args a{};
    for (int i = 0; i < 14; ++i) a.in[i] = (const float*)d_in[i];
    a.out = (float*)d_out; a.ws = (unsigned char*)d_ws; a.pad = 0;
#if MK_SINGLE
    a.ph_lo = 0; a.ph_hi = NPH; a.li = 0;
    hipLaunchKernelGGL(enc_fwd, dim3(grid), dim3(NWAVES * 64), LDS_BYTES, stream, a);
#else
    for (int p = 0; p < NPH; ++p) { a.ph_lo = p; a.ph_hi = p + 1; a.li = p; hipLaunchKernelGGL(enc_fwd, dim3(grid), dim3(NWAVES * 64), LDS_BYTES, stream, a); }
#endif
}
```
